# Optimizing an MI355X kernel written in HIP

```python
import jax, jax.numpy as jnp
from jax import lax
import numpy as np

D_MODEL = 2048
BATCH = 4
SEQ = 2048
DEPTH = 2

HEAD_DIM = 128
FOX_HEADS = 8
DSA_HEADS = 8
IDX_HEADS = 16
IDX_DIM = 64
IDX_TOPK_MAX = 256
SWA_HEADS = 32
SWA_KV_HEADS = 4
SWA_HEAD_DIM = 64
SWA_WINDOW = 128
Q_BLOCK = 128
DSA_Q_BLOCK = 64
ROPE_THETA = 10000.0
EPS = 1e-6
NEG = -1e30

FOX_W = FOX_HEADS * HEAD_DIM
DSA_W = DSA_HEADS * HEAD_DIM
SWA_W = SWA_HEADS * SWA_HEAD_DIM
SWA_KV_W = SWA_KV_HEADS * SWA_HEAD_DIM
EVEN_SPLITS = [FOX_W, FOX_W, FOX_W, FOX_W, FOX_HEADS,
               DSA_W, DSA_W, DSA_W, DSA_W,
               IDX_HEADS * IDX_DIM, IDX_DIM, IDX_HEADS]
EVEN_IN = sum(EVEN_SPLITS)
ODD_SPLITS = [SWA_W, SWA_KV_W, SWA_KV_W, SWA_W]
ODD_IN = sum(ODD_SPLITS)
N_EVEN = (DEPTH + 1) // 2
N_ODD = DEPTH // 2

kernel_name = "hybrid_fox_dsa_swa_gated"


def rmsnorm(x, g):
    xf = x.astype(jnp.float32)
    y = xf * lax.rsqrt(jnp.mean(xf * xf, axis=-1, keepdims=True) + EPS)
    return (y * g.astype(jnp.float32)).astype(x.dtype)


def split_cols(h, sizes):
    return jnp.split(h, np.cumsum(sizes)[:-1].tolist(), axis=-1)


def rope_tables(seq, dim):
    inv = 1.0 / (ROPE_THETA ** (jnp.arange(0, dim, 2, dtype=jnp.float32) / dim))
    ang = jnp.arange(seq, dtype=jnp.float32)[:, None] * inv[None, :]
    return jnp.cos(ang), jnp.sin(ang)


def apply_rope(x, cos, sin):
    x1, x2 = jnp.split(x.astype(jnp.float32), 2, axis=-1)
    c = cos[None, :, None, :]
    s = sin[None, :, None, :]
    return jnp.concatenate([x1 * c - x2 * s, x1 * s + x2 * c], axis=-1).astype(x.dtype)


def fox_attention(q, k, v, log_f):
    B, S, H, D = q.shape
    nb = S // Q_BLOCK
    c = jnp.cumsum(log_f, axis=1).transpose(0, 2, 1)
    qb = q.reshape(B, nb, Q_BLOCK, H, D).transpose(1, 0, 2, 3, 4)
    cb = c.reshape(B, H, nb, Q_BLOCK).transpose(2, 0, 1, 3)
    kpos = jnp.arange(S)
    scale = D ** -0.5

    def block(args):
        i, qi, ci = args
        qpos = i * Q_BLOCK + jnp.arange(Q_BLOCK)
        s = jnp.einsum('bqhd,bkhd->bhqk', qi, k).astype(jnp.float32) * scale
        s = s + ci[..., None] - c[:, :, None, :]
        s = jnp.where((kpos[None, :] <= qpos[:, None])[None, None], s, NEG)
        p = jax.nn.softmax(s, axis=-1)
        return jnp.einsum('bhqk,bkhd->bqhd', p.astype(v.dtype), v)

    out = lax.map(block, (jnp.arange(nb), qb, cb))
    return out.transpose(1, 0, 2, 3, 4).reshape(B, S, H, D)


def dsa_attention(q, k, v, iq, ik, iw, topk):
    B, S, H, D = q.shape
    nb = S // DSA_Q_BLOCK
    qb = q.reshape(B, nb, DSA_Q_BLOCK, H, D).transpose(1, 0, 2, 3, 4)
    iqb = iq.reshape(B, nb, DSA_Q_BLOCK, IDX_HEADS, IDX_DIM).transpose(1, 0, 2, 3, 4)
    iwb = iw.reshape(B, nb, DSA_Q_BLOCK, IDX_HEADS).transpose(1, 0, 2, 3)
    kpos = jnp.arange(S)
    gather = jax.vmap(lambda xb, ib: xb[ib])

    def block(args):
        i, qi, iqi, iwi = args
        qpos = i * DSA_Q_BLOCK + jnp.arange(DSA_Q_BLOCK)
        logits = jnp.einsum('bqhd,bkd->bqhk', iqi, ik).astype(jnp.float32) * IDX_DIM ** -0.5
        score = jnp.einsum('bqh,bqhk->bqk', iwi.astype(jnp.float32), jax.nn.relu(logits))
        score = jnp.where((kpos[None, :] <= qpos[:, None])[None], score, NEG)
        _, idx = lax.top_k(score, topk)
        valid = idx <= qpos[None, :, None]
        ks = gather(k, idx)
        vs = gather(v, idx)
        s = jnp.einsum('bqhd,bqkhd->bhqk', qi, ks).astype(jnp.float32) * D ** -0.5
        s = jnp.where(valid[:, None], s, NEG)
        p = jax.nn.softmax(s, axis=-1)
        return jnp.einsum('bhqk,bqkhd->bqhd', p.astype(v.dtype), vs)

    out = lax.map(block, (jnp.arange(nb), qb, iqb, iwb))
    return out.transpose(1, 0, 2, 3, 4).reshape(B, S, H, D)


def swa_attention(q, k, v, sinks):
    B, S, HQ, D = q.shape
    HKV = k.shape[2]
    G = HQ // HKV
    W = SWA_WINDOW
    nb = S // W
    qb = q.reshape(B, nb, W, HKV, G, D)

    def band(t):
        tb = t.reshape(B, nb, W, HKV, D)
        prev = jnp.pad(tb, ((0, 0), (1, 0), (0, 0), (0, 0), (0, 0)))[:, :-1]
        return jnp.concatenate([prev, tb], axis=2)

    kb, vb = band(k), band(v)
    s = jnp.einsum('bnqhgd,bnkhd->bnhgqk', qb, kb).astype(jnp.float32) * D ** -0.5
    kpos = jnp.arange(2 * W)[None, :]
    rel = (jnp.arange(W)[:, None] + W) - kpos
    mask = (rel >= 0) & (rel < W)
    mask = mask[None] & ((jnp.arange(nb)[:, None, None] > 0) | (kpos >= W)[None])
    s = jnp.where(mask[None, :, None, None], s, NEG)
    sink = jnp.broadcast_to(sinks.reshape(HKV, G).astype(jnp.float32)[None, None, :, :, None, None],
                            s.shape[:-1] + (1,))
    p = jax.nn.softmax(jnp.concatenate([s, sink], axis=-1), axis=-1)[..., :-1]
    o = jnp.einsum('bnhgqk,bnkhd->bnqhgd', p.astype(v.dtype), vb)
    return o.reshape(B, S, HQ, D)


def even_layer(x, g_norm, w_in, b_f, g_qk_fox, g_qk_dsa, g_kidx, w_out, rope128, rope64, topk):
    B, S, _ = x.shape
    h = rmsnorm(x, g_norm) @ w_in
    aq, ak, av, ag, af, bq, bk, bv, bg, iq, ik, iw = split_cols(h, EVEN_SPLITS)
    aq = rmsnorm(aq.reshape(B, S, FOX_HEADS, HEAD_DIM), g_qk_fox[0])
    ak = rmsnorm(ak.reshape(B, S, FOX_HEADS, HEAD_DIM), g_qk_fox[1])
    log_f = jax.nn.log_sigmoid((af + b_f).astype(jnp.float32))
    ya = fox_attention(aq, ak, av.reshape(B, S, FOX_HEADS, HEAD_DIM), log_f)
    ya = ya.reshape(B, S, FOX_W) * jax.nn.silu(ag)
    bq = apply_rope(rmsnorm(bq.reshape(B, S, DSA_HEADS, HEAD_DIM), g_qk_dsa[0]), *rope128)
    bk = apply_rope(rmsnorm(bk.reshape(B, S, DSA_HEADS, HEAD_DIM), g_qk_dsa[1]), *rope128)
    iq = apply_rope(iq.reshape(B, S, IDX_HEADS, IDX_DIM), *rope64)
    ik = apply_rope(rmsnorm(ik, g_kidx)[:, :, None, :], *rope64)[:, :, 0]
    iw = iw * IDX_HEADS ** -0.5
    yb = dsa_attention(bq, bk, bv.reshape(B, S, DSA_HEADS, HEAD_DIM), iq, ik, iw, topk)
    yb = yb.reshape(B, S, DSA_W) * jax.nn.silu(bg)
    return x + jnp.concatenate([ya, yb], axis=-1) @ w_out


def odd_layer(x, g_norm, w_in, g_qk, sinks, w_out, rope64):
    B, S, _ = x.shape
    h = rmsnorm(x, g_norm) @ w_in
    q, k, v, g = split_cols(h, ODD_SPLITS)
    q = apply_rope(rmsnorm(q.reshape(B, S, SWA_HEADS, SWA_HEAD_DIM), g_qk[0]), *rope64)
    k = apply_rope(rmsnorm(k.reshape(B, S, SWA_KV_HEADS, SWA_HEAD_DIM), g_qk[1]), *rope64)
    v = v.reshape(B, S, SWA_KV_HEADS, SWA_HEAD_DIM)
    y = swa_attention(q, k, v, sinks).reshape(B, S, SWA_W) * jax.nn.silu(g)
    return x + y @ w_out


def setup_inputs(seed: int = 0) -> dict:
    key = jax.random.key(seed)
    ks = jax.random.split(key, 13)
    nrm = lambda k, shape, s: jax.random.normal(k, shape, jnp.float32) * s
    gain = lambda k, shape: 1.0 + 0.02 * jax.random.normal(k, shape, jnp.float32)
    return {
        "x": nrm(ks[0], (BATCH, SEQ, D_MODEL), 1.0),
        "norm_even": gain(ks[1], (N_EVEN, D_MODEL)),
        "w_in_even": nrm(ks[2], (N_EVEN, D_MODEL, EVEN_IN), D_MODEL ** -0.5),
        "b_f_even": nrm(ks[3], (N_EVEN, FOX_HEADS), 0.1),
        "g_qk_fox": gain(ks[4], (N_EVEN, 2, HEAD_DIM)),
        "g_qk_dsa": gain(ks[5], (N_EVEN, 2, HEAD_DIM)),
        "g_kidx": gain(ks[6], (N_EVEN, IDX_DIM)),
        "w_out_even": nrm(ks[7], (N_EVEN, FOX_W + DSA_W, D_MODEL), (FOX_W + DSA_W) ** -0.5),
        "norm_odd": gain(ks[8], (N_ODD, D_MODEL)),
        "w_in_odd": nrm(ks[9], (N_ODD, D_MODEL, ODD_IN), D_MODEL ** -0.5),
        "g_qk_swa": gain(ks[10], (N_ODD, 2, SWA_HEAD_DIM)),
        "sinks": nrm(ks[11], (N_ODD, SWA_HEADS), 0.5),
        "w_out_odd": nrm(ks[12], (N_ODD, SWA_W, D_MODEL), SWA_W ** -0.5),
    }


def reference(x, norm_even, w_in_even, b_f_even, g_qk_fox, g_qk_dsa, g_kidx, w_out_even,
              norm_odd, w_in_odd, g_qk_swa, sinks, w_out_odd):
    S = x.shape[1]
    topk = min(IDX_TOPK_MAX, S // 4)
    rope128 = rope_tables(S, HEAD_DIM)
    rope64 = rope_tables(S, IDX_DIM)
    for layer in range(DEPTH):
        j = layer // 2
        if layer % 2 == 0:
            x = even_layer(x, norm_even[j], w_in_even[j], b_f_even[j], g_qk_fox[j], g_qk_dsa[j],
                           g_kidx[j], w_out_even[j], rope128, rope64, topk)
        else:
            x = odd_layer(x, norm_odd[j], w_in_odd[j], g_qk_swa[j], sinks[j], w_out_odd[j], rope64)
    return x
```

```cpp
#include <hip/hip_runtime.h>
#include <hip/hip_cooperative_groups.h>
#include <cstdio>
#include <cstdint>
namespace cg = cooperative_groups;
namespace pg8 {
#define PG8_LAS __attribute__((address_space(3)))
typedef unsigned short bf16_t;
typedef short bf16x8 __attribute__((ext_vector_type(8)));
typedef float f32x4 __attribute__((ext_vector_type(4)));
typedef unsigned u32x4 __attribute__((ext_vector_type(4)));
constexpr int BM = 256, BK = 64, HALF = 128, HTB = HALF * BK * 2  , STAGE_BYTES = 8 * HTB, NXCD = 8, WGM = 8;

__host__ __device__ __forceinline__ int lds_byte(int r, int c) { const int st = (r >> 4) * 2 + (c >> 5), rr = r & 15, cc = c & 31, ob = rr * 64 + cc * 2; return st * 1024 + (ob ^ (((ob >> 9) & 1) << 5)); }
__host__ __device__ __forceinline__ void stage_rc(int b, int& R, int& C) { const int st = b / 1024, sb = b % 1024, swz = sb ^ (((sb >> 9) & 1) << 5); R = (st >> 1) * 16 + swz / 64; C = (st & 1) * 32 + (swz % 64) / 2; }
__host__ __device__ __forceinline__ int perm32(int rho) { const int n = rho >> 4, i = rho & 15; return 8 * (i >> 2) + 4 * n + (i & 3); }

struct Unit { int pm, pn; };
struct Gemm { const bf16_t* A; const bf16_t* Bt; int M, N, K; };

struct StaticOrder {
    int nM, nN, nwg, G, c;
    __host__ __device__ void init(int M, int N, int G_, int c_) { nM = M / BM; nN = N / BM; nwg = nM * nN; G = G_; c = c_; }
    __host__ __device__ bool next(int i, Unit& u) const {
        const long L = (long)i * G + c; if (L >= nwg) return false;
        int wgid = (int)L; { const int q = nwg / NXCD, r = nwg % NXCD, xcd = wgid % NXCD, off = wgid / NXCD; wgid = (xcd < r ? xcd * (q + 1) : r * (q + 1) + (xcd - r) * q) + off; }
        const int nig = WGM * nN, gid = wgid / nig, fm = gid * WGM, gsz = (nM - fm) < WGM ? (nM - fm) : WGM;
        u.pm = fm + ((wgid % nig) % gsz); u.pn = (wgid % nig) / gsz; return true;
    }
    __device__ __forceinline__ void a_ready(const Unit&) const {}
    __device__ __forceinline__ void done(const Unit&) const {}
};

typedef float f32x2v __attribute__((ext_vector_type(2)));
typedef __bf16 bf16x2v __attribute__((ext_vector_type(2)));
__device__ __forceinline__ unsigned cvt_pk_bf16(float lo, float hi) { f32x2v v = {lo, hi}; bf16x2v b = __builtin_convertvector(v, bf16x2v); return __builtin_bit_cast(unsigned, b); }

struct EpiBf16 {
    static constexpr bool PERM = true, AFTER_DRAIN = false;
    bf16_t* O; int ldc; float* side; int side_pn; const float* ss; int smode;
    __device__ __forceinline__ void operator()(const f32x4 (&acc)[2][2][4][2], const Unit& u, int wr, int wc, int fr, int fq) const {
        const int row0 = u.pm * BM + wr * 64 + fr; const int colt = u.pn * BM;
        const int col0 = colt + wc * 32 + 8 * fq;
#pragma unroll
        for (int ai = 0; ai < 2; ++ai)
#pragma unroll
            for (int m = 0; m < 4; ++m) { bf16_t* rowp = O + (size_t)(row0 + ai * HALF + m * 16) * ldc + col0;
#pragma unroll
                for (int bj = 0; bj < 2; ++bj) { f32x4 v0 = acc[ai][bj][m][0], v1 = acc[ai][bj][m][1];
                    if (smode == 1) { const float rs = 1.f / sqrtf(ss[row0 + ai * HALF + m * 16] * (1.f / 2048.f) + 1e-6f); v0 = v0 * rs; v1 = v1 * rs; }
                    else if (smode == 2) { const f32x4 s0 = *(const f32x4*)(ss + col0 + bj * HALF), s1 = *(const f32x4*)(ss + col0 + bj * HALF + 4);
#pragma unroll
                        for (int e = 0; e < 4; ++e) { v0[e] *= 1.f / sqrtf(s0[e] * (1.f / 2048.f) + 1e-6f); v1[e] *= 1.f / sqrtf(s1[e] * (1.f / 2048.f) + 1e-6f); } }
                    u32x4 w; w.x = cvt_pk_bf16(v0[0], v0[1]); w.y = cvt_pk_bf16(v0[2], v0[3]); w.z = cvt_pk_bf16(v1[0], v1[1]); w.w = cvt_pk_bf16(v1[2], v1[3]);
                    *(u32x4*)(rowp + bj * HALF) = w; } }
        if (side != nullptr && u.pn == side_pn) {
#pragma unroll
            for (int ai = 0; ai < 2; ++ai)
#pragma unroll
                for (int m = 0; m < 4; ++m) { float* sp = side + (size_t)(row0 + ai * HALF + m * 16) * 256 + wc * 32 + 8 * fq;
#pragma unroll
                    for (int bj = 0; bj < 2; ++bj) { *(f32x4*)(sp + bj * HALF) = acc[ai][bj][m][0]; *(f32x4*)(sp + bj * HALF + 4) = acc[ai][bj][m][1]; } }
        }
    }
};
struct EpiResF32 {
    static constexpr bool PERM = false, AFTER_DRAIN = false;
    const float* base; float* out; int ldc;
    __device__ __forceinline__ void operator()(const f32x4 (&acc)[2][2][4][2], const Unit& u, int wr, int wc, int fr, int fq) const {
        const int col0 = u.pn * BM + wc * 32 + 4 * fq;
#pragma unroll
        for (int ai = 0; ai < 2; ++ai)
#pragma unroll
            for (int m = 0; m < 4; ++m) { const size_t off = (size_t)(u.pm * BM + ai * HALF + wr * 64 + m * 16 + fr) * ldc + col0;
#pragma unroll
                for (int bj = 0; bj < 2; ++bj)
#pragma unroll
                    for (int n = 0; n < 2; ++n) { const f32x4 bs = *(const f32x4*)(base + off + bj * HALF + n * 16); *(f32x4*)(out + off + bj * HALF + n * 16) = bs + acc[ai][bj][m][n]; } }
    }
};

struct EpiResXg {
    static constexpr bool PERM = false, AFTER_DRAIN = false;
    const float* base; float* out; int ldc; const float* gain; bf16_t* xg; float* ss;
    __device__ __forceinline__ void operator()(const f32x4 (&acc)[2][2][4][2], const Unit& u, int wr, int wc, int fr, int fq) const {
        const int col0 = u.pn * BM + wc * 32 + 4 * fq;
        f32x4 gv[2][2];
#pragma unroll
        for (int bj = 0; bj < 2; ++bj)
#pragma unroll
            for (int n = 0; n < 2; ++n) gv[bj][n] = *(const f32x4*)(gain + col0 + bj * HALF + n * 16);
#pragma unroll
        for (int ai = 0; ai < 2; ++ai)
#pragma unroll
            for (int m = 0; m < 4; ++m) { const int row = u.pm * BM + ai * HALF + wr * 64 + m * 16 + fr; const size_t off = (size_t)row * ldc + col0; float part = 0.f;
#pragma unroll
                for (int bj = 0; bj < 2; ++bj)
#pragma unroll
                    for (int n = 0; n < 2; ++n) { const f32x4 x1 = *(const f32x4*)(base + off + bj * HALF + n * 16) + acc[ai][bj][m][n];
                        *(f32x4*)(out + off + bj * HALF + n * 16) = x1; part += (x1[0] * x1[0] + x1[1] * x1[1]) + (x1[2] * x1[2] + x1[3] * x1[3]);
                        const f32x4 y = x1 * gv[bj][n]; unsigned long long pk = (unsigned long long)cvt_pk_bf16(y[0], y[1]) | ((unsigned long long)cvt_pk_bf16(y[2], y[3]) << 32);
                        *(unsigned long long*)(xg + off + bj * HALF + n * 16) = pk; }
                part += __shfl_xor(part, 16); part += __shfl_xor(part, 32);
                if (fq == 0) atomicAdd(ss + row, part); }
    }
};

struct HalfDesc { int type; const float* gain; int rope; float scale; int plain_hi; };
struct EpiProj {
    static constexpr bool PERM = true, AFTER_DRAIN = false;
    bf16_t* O; int ldc; float* side; int side_pn; const float* ss; int smode; int layer;
    const float* ga; const float* gb; const float* gc; const float* rope; PG8_LAS float* xch; float qs;
    __device__ __forceinline__ HalfDesc desc(int ht) const {
        if (layer == 0) {
            if (ht < 8)  return HalfDesc{1, ga, -1, qs, 0};
            if (ht < 16) return HalfDesc{1, ga + 128, -1, 1.f, 0};
            if (ht < 24) return HalfDesc{0, nullptr, -1, 1.f, 0};
            if (ht < 32) return HalfDesc{1, gb, 0, qs, 0};
            if (ht < 40) return HalfDesc{1, gb + 128, 0, 1.f, 0};
            if (ht < 48) return HalfDesc{0, nullptr, -1, 1.f, 0};
            if (ht < 56) return HalfDesc{2, nullptr, 64, 1.f, 0};
            if (ht == 56) return HalfDesc{2, gc, 64, 1.f, 1};
            return HalfDesc{0, nullptr, -1, 1.f, 0};
        }
        if (ht < 16) return HalfDesc{2, ga, 64, qs, 0};
        if (ht < 18) return HalfDesc{2, ga + 64, 64, 1.f, 0};
        return HalfDesc{0, nullptr, -1, 1.f, 0};
    }
    __device__ __forceinline__ void operator()(f32x4 (&acc)[2][2][4][2], const Unit& u, int wr, int wc, int fr, int fq) const {
        const int row0 = u.pm * BM + wr * 64 + fr; const int col0 = u.pn * BM + wc * 32 + 8 * fq;
        const HalfDesc d0 = desc(2 * u.pn), d1 = desc(2 * u.pn + 1);
        if (smode == 1) {
#pragma unroll
            for (int ai = 0; ai < 2; ++ai)
#pragma unroll
                for (int m = 0; m < 4; ++m) { const float rs = 1.f / sqrtf(ss[row0 + ai * HALF + m * 16] * (1.f / 2048.f) + 1e-6f);
#pragma unroll
                    for (int bj = 0; bj < 2; ++bj) { acc[ai][bj][m][0] = acc[ai][bj][m][0] * rs; acc[ai][bj][m][1] = acc[ai][bj][m][1] * rs; } }
        }
        const bool nx0 = (d0.type != 0) && (d0.gain != nullptr), nx1 = (d1.type != 0) && (d1.gain != nullptr);
        if (nx0 || nx1) {
#pragma unroll
            for (int ai = 0; ai < 2; ++ai)
#pragma unroll
                for (int m = 0; m < 4; ++m)
#pragma unroll
                    for (int bj = 0; bj < 2; ++bj) { if (bj == 0 ? nx0 : nx1) { const f32x4 a0 = acc[ai][bj][m][0], a1 = acc[ai][bj][m][1];
                        float p = ((a0[0] * a0[0] + a0[1] * a0[1]) + (a0[2] * a0[2] + a0[3] * a0[3])) + ((a1[0] * a1[0] + a1[1] * a1[1]) + (a1[2] * a1[2] + a1[3] * a1[3]));
                        p += __shfl_xor(p, 16); p += __shfl_xor(p, 32);
                        if (fq == 0) xch[((ai * HALF + wr * 64 + m * 16 + fr) * 2 + bj) * 4 + wc] = p; } }
            asm volatile("s_waitcnt lgkmcnt(0)" ::: "memory"); __builtin_amdgcn_s_barrier(); asm volatile("" ::: "memory");
        }
        bool act[2], nrm[2], rpo[2]; int hdv[2]; f32x4 gA[2], gB[2], fQ[2];
#pragma unroll
        for (int bj = 0; bj < 2; ++bj) { const HalfDesc d = bj ? d1 : d0;
            act[bj] = d.type != 0 && !(d.plain_hi && wc >= 2); nrm[bj] = act[bj] && d.gain != nullptr; rpo[bj] = act[bj] && d.rope >= 0; hdv[bj] = (d.type == 1) ? 128 : 64;
            const int g = (d.type == 1) ? 4 * wc + fq : 4 * (wc & 1) + fq; const int i0 = (d.rope >= 0) ? 4 * g : 8 * g, i1 = (d.rope >= 0) ? hdv[bj] / 2 + 4 * g : 8 * g + 4;
            gA[bj] = (f32x4){1.f, 1.f, 1.f, 1.f}; gB[bj] = gA[bj]; fQ[bj] = (f32x4){0.f, 0.f, 0.f, 0.f};
            if (nrm[bj]) { gA[bj] = *(const f32x4*)(d.gain + i0) * d.scale; gB[bj] = *(const f32x4*)(d.gain + i1) * d.scale; }
            if (rpo[bj]) fQ[bj] = *(const f32x4*)(rope + d.rope + 4 * g); }
#pragma unroll
        for (int ai = 0; ai < 2; ++ai)
#pragma unroll
            for (int m = 0; m < 4; ++m) { const int row = row0 + ai * HALF + m * 16; bf16_t* rowp = O + (size_t)row * ldc + col0; const float sf = (float)(row & 2047);
#pragma unroll
                for (int bj = 0; bj < 2; ++bj) { const HalfDesc d = bj ? d1 : d0; f32x4 v0 = acc[ai][bj][m][0], v1 = acc[ai][bj][m][1];
                    if (act[bj]) {
                        const int hd = hdv[bj];
                        const bool rp_on = rpo[bj];
                        if (nrm[bj]) { const PG8_LAS float* xp = xch + ((ai * HALF + wr * 64 + m * 16 + fr) * 2 + bj) * 4;
                            const float tot = (d.type == 1) ? ((xp[0] + xp[1]) + (xp[2] + xp[3])) : (xp[wc & 2] + xp[(wc & 2) + 1]);
                            const float r = __builtin_amdgcn_rsqf(tot * (1.f / (float)hd) + 1e-6f);
                            v0 = v0 * (gA[bj] * r); v1 = v1 * (gB[bj] * r); }
                        if (rp_on) { const f32x4 fq4 = fQ[bj];
                            f32x4 c, sn;
#pragma unroll
                            for (int e = 0; e < 4; ++e) { const float rv = __builtin_amdgcn_fractf(sf * fq4[e]); c[e] = __builtin_amdgcn_cosf(rv); sn[e] = __builtin_amdgcn_sinf(rv); }
                            const f32x4 o0 = v0 * c - v1 * sn, o1 = v0 * sn + v1 * c; v0 = o0; v1 = o1; }
                    }
                    u32x4 w; w.x = cvt_pk_bf16(v0[0], v0[1]); w.y = cvt_pk_bf16(v0[2], v0[3]); w.z = cvt_pk_bf16(v1[0], v1[1]); w.w = cvt_pk_bf16(v1[2], v1[3]);
                    *(u32x4*)(rowp + bj * HALF) = w; } }
        if (side != nullptr && u.pn == side_pn) {
#pragma unroll
            for (int ai = 0; ai < 2; ++ai)
#pragma unroll
                for (int m = 0; m < 4; ++m) { float* sp = side + (size_t)(row0 + ai * HALF + m * 16) * 256 + wc * 32 + 8 * fq;
#pragma unroll
                    for (int bj = 0; bj < 2; ++bj) { *(f32x4*)(sp + bj * HALF) = acc[ai][bj][m][0]; *(f32x4*)(sp + bj * HALF + 4) = acc[ai][bj][m][1]; } }
        }
    }
};

template <class Epi, class Sched, bool ALIGN_EPI = false, bool SP2 = false>
__device__ __forceinline__ void gemm_phase(PG8_LAS unsigned char* lds, const Gemm g, const Sched& S, const Epi& E) {
    int tid_ = threadIdx.x; asm volatile("" : "+v"(tid_)); const int tid = tid_, wid = __builtin_amdgcn_readfirstlane(tid >> 6), lane = tid & 63, wr = wid >> 2, wc = wid & 3, fr = lane & 15, fq = lane >> 4;
    const int K = g.K, nt = K / BK;
    unsigned voffA[2], voffB[2];
#pragma unroll
    for (int i = 0; i < 2; ++i) { int R, C; stage_rc(tid * 16 + i * 8192, R, C); const int Rb = Epi::PERM ? ((R & ~31) + perm32(R & 31)) : R;
        voffA[i] = (unsigned)(R * K + C) * 2u; voffB[i] = (unsigned)(Rb * K + C) * 2u; }
    const size_t kstep = (size_t)(BK * 2);
    const size_t hstep = (size_t)HALF * K * 2;
    const size_t tstep = 2 * hstep;
    const unsigned ldsw = (unsigned)wid * 1024u;
    const int aoff = lds_byte(wr * 64 + fr, fq * 8), boff = lds_byte(wc * 32 + fr, fq * 8);
#define PG8_SA(b, h) (((b) * 2 + (h)) * HTB)
#define PG8_SB(b, h) ((4 + (b) * 2 + (h)) * HTB)
#define PG8_STAGE(bufoff, gbase, voff) do { _Pragma("unroll") for (int _i = 0; _i < 2; ++_i) \
        __builtin_amdgcn_global_load_lds((const unsigned*)((const char*)(gbase) + (voff)[_i]), (PG8_LAS unsigned*)(lds + (bufoff) + ldsw + _i * 8192), 16, 0, 0); } while (0)
#define PG8_LDA(dst, b, h) do { _Pragma("unroll") for (int m = 0; m < 4; ++m) _Pragma("unroll") for (int k = 0; k < 2; ++k) dst[m][k] = *(const PG8_LAS bf16x8*)(lds + PG8_SA(b, h) + aoff + m * 2048 + k * 1024); } while (0)
#define PG8_LDB(dst, b, h) do { _Pragma("unroll") for (int n = 0; n < 2; ++n) _Pragma("unroll") for (int k = 0; k < 2; ++k) dst[n][k] = *(const PG8_LAS bf16x8*)(lds + PG8_SB(b, h) + boff + n * 2048 + k * 1024); } while (0)
#define PG8_MMA(ai, bj, At, Bt) do { __builtin_amdgcn_s_setprio(1); _Pragma("unroll") for (int m = 0; m < 4; ++m) _Pragma("unroll") for (int n = 0; n < 2; ++n) _Pragma("unroll") for (int k = 0; k < 2; ++k) \
        acc[ai][bj][m][n] = __builtin_amdgcn_mfma_f32_16x16x32_bf16(Bt[n][k], At[m][k], acc[ai][bj][m][n], 0, 0, 0); __builtin_amdgcn_s_setprio(0); } while (0)
#define PG8_WAIT_V(n) asm volatile("s_waitcnt vmcnt(" #n ")" ::: "memory")
#define PG8_WAIT_L(n) asm volatile("s_waitcnt lgkmcnt(" #n ")" ::: "memory")
#define PG8_BAR __builtin_amdgcn_s_barrier()
#define PG8_SCHED __builtin_amdgcn_sched_barrier(0)
    Unit cur, nxt; int ui = 0;
    if (!S.next(0, cur)) return;
    f32x4 acc[2][2][4][2];
#pragma unroll
    for (int a = 0; a < 2; ++a)
#pragma unroll
        for (int b = 0; b < 2; ++b)
#pragma unroll
            for (int m = 0; m < 4; ++m)
#pragma unroll
                for (int n = 0; n < 2; ++n) acc[a][b][m][n] = (f32x4){0.f, 0.f, 0.f, 0.f};
    bf16x8 At[4][2], B0[2][2], B1[2][2];
    const char* cA = (const char*)g.A + (size_t)cur.pm * tstep; const char* cB = (const char*)g.Bt + (size_t)cur.pn * tstep;
    S.a_ready(cur);
    if constexpr (SP2) {
        PG8_STAGE(PG8_SB(0, 0), cB, voffB); PG8_STAGE(PG8_SB(0, 1), cB + hstep, voffB); PG8_STAGE(PG8_SA(0, 0), cA, voffA); PG8_STAGE(PG8_SA(0, 1), cA + hstep, voffA);
        if (wr == 1) PG8_BAR;
        PG8_WAIT_V(2); PG8_BAR;
        PG8_STAGE(PG8_SB(1, 0), cB + kstep, voffB); PG8_STAGE(PG8_SA(1, 0), cA + kstep, voffA); PG8_STAGE(PG8_SB(1, 1), cB + hstep + kstep, voffB);
        PG8_WAIT_V(6); PG8_BAR;
    } else {
        PG8_STAGE(PG8_SB(0, 0), cB, voffB); PG8_STAGE(PG8_SA(0, 0), cA, voffA); PG8_STAGE(PG8_SB(0, 1), cB + hstep, voffB); PG8_STAGE(PG8_SA(0, 1), cA + hstep, voffA);
        if (wr == 1) PG8_BAR;
        PG8_WAIT_V(4); PG8_BAR;
        PG8_STAGE(PG8_SB(1, 0), cB + kstep, voffB); PG8_STAGE(PG8_SA(1, 0), cA + kstep, voffA); PG8_STAGE(PG8_SB(1, 1), cB + hstep + kstep, voffB);
        PG8_WAIT_V(6); PG8_BAR;
    }
    for (;;) {
        const bool has_next = S.next(ui + 1, nxt);
        const char* nA = has_next ? (const char*)g.A + (size_t)nxt.pm * tstep : cA; const char* nB = has_next ? (const char*)g.Bt + (size_t)nxt.pn * tstep : cB;
        for (int t = 0; t < nt; t += 2) {
            const bool last = (t == nt - 2);
            const char* a1 = cA + (size_t)(t + 1) * kstep;
            const char* a2 = last ? nA : cA + (size_t)(t + 2) * kstep; const char* b2 = last ? nB : cB + (size_t)(t + 2) * kstep;
            const char* a3 = a2 + kstep; const char* b3 = b2 + kstep;
            if (last && has_next) S.a_ready(nxt);
            if constexpr (SP2) {
            PG8_LDB(B0, 0, 0); PG8_LDB(B1, 0, 1); PG8_SCHED; PG8_LDA(At, 0, 0); PG8_STAGE(PG8_SA(1, 1), a1 + hstep, voffA);
            PG8_WAIT_V(8); PG8_WAIT_L(0); PG8_BAR; PG8_MMA(0, 0, At, B0); PG8_MMA(0, 1, At, B1); PG8_BAR; PG8_SCHED;
            PG8_LDA(At, 0, 1); PG8_STAGE(PG8_SB(0, 0), b2, voffB); PG8_STAGE(PG8_SB(0, 1), b2 + hstep, voffB); PG8_STAGE(PG8_SA(0, 0), a2, voffA);
            PG8_WAIT_V(8); PG8_WAIT_L(0); PG8_BAR; PG8_MMA(1, 0, At, B0); PG8_MMA(1, 1, At, B1); PG8_BAR; PG8_SCHED;
            PG8_LDB(B0, 1, 0); PG8_LDB(B1, 1, 1); PG8_SCHED; PG8_LDA(At, 1, 0); PG8_STAGE(PG8_SA(0, 1), a2 + hstep, voffA);
            PG8_WAIT_V(8); PG8_WAIT_L(0); PG8_BAR; PG8_MMA(0, 0, At, B0); PG8_MMA(0, 1, At, B1); PG8_BAR; PG8_SCHED;
            PG8_LDA(At, 1, 1); PG8_STAGE(PG8_SB(1, 0), b3, voffB); PG8_STAGE(PG8_SB(1, 1), b3 + hstep, voffB); PG8_STAGE(PG8_SA(1, 0), a3, voffA);
            PG8_WAIT_V(8); PG8_WAIT_L(0); PG8_BAR; PG8_MMA(1, 0, At, B0); PG8_MMA(1, 1, At, B1); PG8_BAR; PG8_SCHED;
            } else {
            PG8_LDB(B0, 0, 0); PG8_SCHED; PG8_LDA(At, 0, 0); PG8_STAGE(PG8_SA(1, 1), a1 + hstep, voffA);
            PG8_WAIT_L(8); PG8_BAR; PG8_WAIT_L(0); PG8_MMA(0, 0, At, B0); PG8_BAR; PG8_SCHED;
            PG8_LDB(B1, 0, 1); PG8_STAGE(PG8_SB(0, 0), b2, voffB);
            PG8_BAR; PG8_WAIT_L(0); PG8_MMA(0, 1, At, B1); PG8_BAR;
            PG8_LDA(At, 0, 1); PG8_STAGE(PG8_SA(0, 0), a2, voffA);
            PG8_BAR; PG8_WAIT_L(0); PG8_MMA(1, 0, At, B0); PG8_BAR; PG8_SCHED;
            PG8_STAGE(PG8_SB(0, 1), b2 + hstep, voffB);
            PG8_WAIT_V(6); PG8_BAR; PG8_MMA(1, 1, At, B1); PG8_BAR;
            PG8_LDB(B0, 1, 0); PG8_SCHED; PG8_LDA(At, 1, 0); PG8_STAGE(PG8_SA(0, 1), a2 + hstep, voffA);
            PG8_WAIT_L(8); PG8_BAR; PG8_WAIT_L(0); PG8_MMA(0, 0, At, B0); PG8_BAR; PG8_SCHED;
            PG8_LDB(B1, 1, 1); PG8_STAGE(PG8_SB(1, 0), b3, voffB);
            PG8_BAR; PG8_WAIT_L(0); PG8_MMA(0, 1, At, B1); PG8_BAR;
            PG8_LDA(At, 1, 1); PG8_STAGE(PG8_SA(1, 0), a3, voffA);
            PG8_BAR; PG8_WAIT_L(0); PG8_MMA(1, 0, At, B0); PG8_BAR; PG8_SCHED;
            PG8_STAGE(PG8_SB(1, 1), b3 + hstep, voffB);
            PG8_WAIT_V(6); PG8_BAR; PG8_MMA(1, 1, At, B1); PG8_BAR;
            }
        }
        if constexpr (ALIGN_EPI) { if (wr == 0) PG8_BAR; }
        if constexpr (!Epi::AFTER_DRAIN) { E(acc, cur, wr, wc, fr, fq); S.done(cur); }
        if (!has_next) break;
#pragma unroll
        for (int a = 0; a < 2; ++a)
#pragma unroll
            for (int b = 0; b < 2; ++b)
#pragma unroll
                for (int m = 0; m < 4; ++m)
#pragma unroll
                    for (int n = 0; n < 2; ++n) acc[a][b][m][n] = (f32x4){0.f, 0.f, 0.f, 0.f};
        cur = nxt; cA = nA; cB = nB; ++ui;
        if constexpr (ALIGN_EPI) { if (wr == 1) PG8_BAR; }
    }
    PG8_WAIT_V(0);
    if constexpr (!ALIGN_EPI) { if (wr == 0) PG8_BAR; }
    PG8_BAR;
    if constexpr (Epi::AFTER_DRAIN) { E.fused(acc, cur, wr, wc, fr, fq, lds, wid, lane); S.done(cur); }
#undef PG8_SA
#undef PG8_SB
#undef PG8_STAGE
#undef PG8_LDA
#undef PG8_LDB
#undef PG8_MMA
#undef PG8_WAIT_V
#undef PG8_WAIT_L
#undef PG8_BAR
#undef PG8_SCHED
}
}

#ifndef PROBE_DUP
#define PROBE_DUP -1
#endif
#ifndef PROBE_SYNCS
#define PROBE_SYNCS 0
#endif
#ifndef PROBE_PLAIN
#define PROBE_PLAIN 0
#endif
#ifndef PROBE_IDX
#define PROBE_IDX 0
#endif
#ifndef PROBE_P3
#define PROBE_P3 0
#endif
#define REP(k) ((PROBE_DUP == (k)) ? 3 : 1)
#define LAS __attribute__((address_space(3)))
typedef unsigned short bf16_t;
typedef short bf16x8 __attribute__((ext_vector_type(8)));
typedef float f32x4 __attribute__((ext_vector_type(4)));
typedef float f32x16 __attribute__((ext_vector_type(16)));
typedef unsigned u32x4 __attribute__((ext_vector_type(4)));
typedef unsigned u32x2 __attribute__((ext_vector_type(2)));
typedef float f32x2 __attribute__((ext_vector_type(2)));
typedef unsigned long long u64;
typedef __attribute__((address_space(1))) unsigned long long gu64;

constexpr int NB = 4, SEQ = 2048, DM = 2048, NTOK = NB * SEQ;
constexpr int EVEN_IN = 9304, ODD_IN = 4608;
constexpr int N0 = 7424, N0T = 9472;
constexpr int N1 = 4352, N1T = 4608;
constexpr int C_FQ = 0, C_FK = 1024, C_FG = 2048, C_DQ = 3072, C_DK = 4096, C_DG = 5120, C_IQ = 6144, C_IK = 7168;
constexpr int C1_Q = 0, C1_K = 2048, C1_G = 2304;
constexpr float EPS = 1e-6f, LOG2E = 1.4426950408889634f;

constexpr size_t WS_CTL = 0;
constexpr size_t WS_BAR = 4096, WS_SS = 32768, CTL_BYTES = 65536;
constexpr size_t WS_WT0 = CTL_BYTES;
constexpr size_t WS_WO0 = WS_WT0 + (size_t)N0T * DM * 2;
constexpr size_t WS_WT1 = WS_WO0 + (size_t)DM * DM * 2;
constexpr size_t WS_WO1 = WS_WT1 + (size_t)N1T * DM * 2;
constexpr size_t WS_ACT = WS_WO1 + (size_t)DM * DM * 2;
constexpr size_t WS_H   = WS_ACT + (size_t)NTOK * DM * 2;
constexpr size_t WS_VT  = WS_H + (size_t)NTOK * N0 * 2;
constexpr int VTP = NTOK + 128;
constexpr size_t WS_ROPE = WS_VT + (size_t)2048 * VTP * 2;
constexpr size_t WS_END = WS_ROPE + (size_t)SEQ * 192 * 4;
constexpr size_t DO_SIDE = 0;
constexpr size_t DO_CF = DO_SIDE + (size_t)NTOK * 256 * 4;
constexpr size_t DO_MASK = DO_CF + (size_t)NB * 8 * SEQ * 4;
constexpr size_t DO_PART = 16u << 20;

constexpr int LDS_CTL_OFF = 131072;
constexpr int LDS_XCH_OFF = 131072 + 1024;
constexpr int LDS_IK_OFF = 131072 + 1024 + 8192;
constexpr int LDS_BYTES = 131072 + 1024 + 8192 + 18432;

__device__ __forceinline__ float bf2f(unsigned short h) { return __uint_as_float((unsigned)h << 16); }
__device__ __forceinline__ unsigned f2bf(float f) { unsigned u = __float_as_uint(f); return (u + 0x7fffu + ((u >> 16) & 1u)) >> 16; }
__device__ __forceinline__ unsigned pk2(float lo, float hi) { return f2bf(lo) | (f2bf(hi) << 16); }
__device__ __forceinline__ int tid_fresh() { int t = threadIdx.x; asm volatile("" : "+v"(t)); return t; }
#define LDS_WAIT() asm volatile("s_waitcnt lgkmcnt(0)" ::: "memory")

__device__ __forceinline__ int hperm(int p, int hd) { const int g = p >> 3, e = p & 7; return (e < 4) ? 4 * g + e : hd / 2 + 4 * g + (e - 4); }
__device__ __forceinline__ int srccol(int which, int n) {
    if (which == 0) {
        if (n < 2048) return n;
        if (n < 3072) return n + 1024;
        if (n < 4096) { const int r = n - 3072; return 4104 + (r & ~127) + hperm(r & 127, 128); }
        if (n < 5120) { const int r = n - 4096; return 5128 + (r & ~127) + hperm(r & 127, 128); }
        if (n < 6144) return n - 5120 + 7176;
        if (n < 7168) { const int r = n - 6144; return 8200 + (r & ~63) + hperm(r & 63, 64); }
        if (n < 7232) return 9224 + hperm(n - 7168, 64);
        if (n < 7240) return n - 7232 + 4096;
        if (n < 7256) return n - 7240 + 9288;
        if (n < 7424) return -1;
        if (n < 8448) return n - 7424 + 2048;
        return n - 8448 + 6152;
    } else if (which == 1) {
        if (n < 2304) return (n & ~63) + hperm(n & 63, 64);
        if (n < 4352) return n + 256;
        return n - 4352 + 2304;
    }
    return n;
}
__device__ __forceinline__ void p0_transpose_item(const float* W, int N, int which, bf16_t* WT, LAS float* scr, int item, int nblk, int lane) {
    const int kb = item / nblk, nb = item % nblk, k0 = 64 * kb, n0 = 32 * nb;
    const int n4 = lane & 7, kr = lane >> 3;
    const int sc = srccol(which, n0 + 4 * n4);
    f32x4 v[8];
#pragma unroll
    for (int i = 0; i < 8; ++i) v[i] = (sc >= 0) ? *(const f32x4*)(W + (size_t)(k0 + kr + 8 * i) * N + sc) : (f32x4){0.f, 0.f, 0.f, 0.f};
#pragma unroll
    for (int i = 0; i < 8; ++i) { LAS float* d = scr + (kr + 8 * i) * 33 + 4 * n4; d[0] = v[i][0]; d[1] = v[i][1]; d[2] = v[i][2]; d[3] = v[i][3]; }
    LDS_WAIT(); asm volatile("" ::: "memory");
    const int c = lane & 7;
#pragma unroll
    for (int j = 0; j < 4; ++j) { const int n = (lane >> 3) + 8 * j; const LAS float* s = scr + (8 * c) * 33 + n;
        u32x4 o; o.x = pk2(s[0 * 33], s[1 * 33]); o.y = pk2(s[2 * 33], s[3 * 33]); o.z = pk2(s[4 * 33], s[5 * 33]); o.w = pk2(s[6 * 33], s[7 * 33]);
        *(u32x4*)(WT + (size_t)(n0 + n) * DM + k0 + 8 * c) = o; }
    LDS_WAIT(); asm volatile("" ::: "memory");
}
__device__ __forceinline__ float wave_sum(float v) {
#pragma unroll
    for (int o = 1; o < 64; o <<= 1) v += __shfl_xor(v, o);
    return v;
}
__device__ __forceinline__ void rms_row_to_bf16(const float* xrow, const float* g, bf16_t* orow, int lane) {
    const f32x4* xr = (const f32x4*)xrow + lane; const f32x4* gr = (const f32x4*)g + lane;
    f32x4 v[8]; float s = 0.f;
#pragma unroll
    for (int j = 0; j < 8; ++j) { v[j] = xr[64 * j]; s += (v[j].x * v[j].x + v[j].y * v[j].y) + (v[j].z * v[j].z + v[j].w * v[j].w); }
    const float rstd = 1.f / sqrtf(wave_sum(s) * (1.f / DM) + EPS);
    u64* o8 = (u64*)orow + lane;
#pragma unroll
    for (int j = 0; j < 8; ++j) { const f32x4 gg = gr[64 * j];
        o8[64 * j] = (u64)pk2(v[j].x * rstd * gg.x, v[j].y * rstd * gg.y) | ((u64)pk2(v[j].z * rstd * gg.z, v[j].w * rstd * gg.w) << 32); }
}

template <int DIM, bool NORM, bool ROPEF>
__device__ __forceinline__ void pp_kind(bf16_t* Hb, int pitch, int colbase, int nparts_log2, const float* gain, const float* rope, int cs_off, int sn_off, float scale, int gw, int NGW, int lane) {
    constexpr int G = DIM / 4, BATCH = 4;
    const int grp = lane / G, li = lane % G;
    const int total = NTOK << nparts_log2, pmask = (1 << nparts_log2) - 1;
    float g0 = 1.f, g1 = 1.f, g2 = 1.f, g3 = 1.f;
    if (NORM) { g0 = gain[2 * li]; g1 = gain[2 * li + 1]; g2 = gain[DIM / 2 + 2 * li]; g3 = gain[DIM / 2 + 2 * li + 1]; }
    for (int i0 = gw * BATCH; i0 < total; i0 += NGW * BATCH) {
        unsigned a[BATCH], b[BATCH]; bf16_t* hp[BATCH]; f32x2 cv[BATCH], sv[BATCH];
#pragma unroll
        for (int k = 0; k < BATCH; ++k) { const int idx = i0 + k, tok = idx >> nparts_log2, part = idx & pmask;
            hp[k] = Hb + (size_t)tok * pitch + colbase + 256 * part + grp * DIM;
            a[k] = *(const unsigned*)(hp[k] + 2 * li); b[k] = *(const unsigned*)(hp[k] + DIM / 2 + 2 * li);
            if (ROPEF) { const float* rp = rope + (size_t)(tok & (SEQ - 1)) * 192; cv[k] = *(const f32x2*)(rp + cs_off + 2 * li); sv[k] = *(const f32x2*)(rp + sn_off + 2 * li); } }
#pragma unroll
        for (int k = 0; k < BATCH; ++k) {
            float x1a = bf2f((unsigned short)(a[k] & 0xffffu)), x1b = bf2f((unsigned short)(a[k] >> 16)), x2a = bf2f((unsigned short)(b[k] & 0xffffu)), x2b = bf2f((unsigned short)(b[k] >> 16));
            if (NORM) {
                float ss = (x1a * x1a + x1b * x1b) + (x2a * x2a + x2b * x2b);
#pragma unroll
                for (int o = 1; o < G; o <<= 1) ss += __shfl_xor(ss, o);
                const float rstd = 1.f / sqrtf(ss * (1.f / DIM) + EPS);
                x1a *= rstd * g0; x1b *= rstd * g1; x2a *= rstd * g2; x2b *= rstd * g3;
            }
            if (ROPEF) {
                const float c0 = cv[k].x, c1 = cv[k].y, s0 = sv[k].x, s1 = sv[k].y;
                const float o1a = x1a * c0 - x2a * s0, o2a = x1a * s0 + x2a * c0, o1b = x1b * c1 - x2b * s1, o2b = x1b * s1 + x2b * c1;
                x1a = o1a; x2a = o2a; x1b = o1b; x2b = o2b;
            }
            *(unsigned*)(hp[k] + 2 * li) = pk2(x1a * scale, x1b * scale);
            *(unsigned*)(hp[k] + DIM / 2 + 2 * li) = pk2(x2a * scale, x2b * scale);
        }
    }
}

template <int HD, int MODE>
__device__ __forceinline__ void attn_unit(LAS unsigned char* lds, const bf16_t* Qp, int qpitch, const bf16_t* Kp, int kpitch, const bf16_t* Vtp,
                                          const bf16_t* Gp, int gpitch, bf16_t* Yp, const float* Cfp, const u64* Mp, float sink2, float b2x2, int qb,
                                          int chunk = -1, float* part = nullptr, unsigned* pcnt = nullptr, volatile LAS int* bc = nullptr, const float* Ncp = nullptr) {
    constexpr int KROW = HD * 2 + 16, VROW = 136, KT_BYTES = 64 * KROW, VT_BYTES = HD * VROW, BUF = KT_BYTES + VT_BYTES;
    constexpr int KPT = (64 * HD / 8) / 512, VPT = (HD * 8) / 512, NSTEP = HD / 16, NDB = HD / 32, CPR = HD / 8;
    const int tid = tid_fresh(), lane = tid & 63, w = __builtin_amdgcn_readfirstlane(tid >> 6), l31 = lane & 31, hh = lane >> 5;
    const int q0w = qb * 256 + w * 32, qg = q0w + l31;
    int t_hi = 4 * qb + 3; int t_lo = 0;
    if (MODE == 2) { t_lo = 4 * qb - 2; if (t_lo < 0) t_lo = 0; }
    if (MODE == 1) { if (chunk == 0) t_hi = 15; else if (chunk == 1) t_lo = 16; }
    bf16x8 qf[NSTEP];
#pragma unroll
    for (int s = 0; s < NSTEP; ++s) qf[s] = *(const bf16x8*)(Qp + (size_t)qg * qpitch + 16 * s + 8 * hh);
    f32x16 o[NDB];
#pragma unroll
    for (int d = 0; d < NDB; ++d)
#pragma unroll
        for (int r = 0; r < 16; ++r) o[d][r] = 0.f;
    float m = -INFINITY, l = 0.f;
    if (MODE == 2) { m = sink2; l = (hh == 0) ? 1.f : 0.f; }
    if (MODE == 1) m = 0.f;
    u32x4 kreg[KPT], vreg[VPT];
#define AT_GLOAD(t) do { _Pragma("unroll") for (int i_ = 0; i_ < KPT; ++i_) { const int c_ = tid + 512 * i_; const int row_ = c_ / CPR, ch_ = c_ % CPR; \
            kreg[i_] = *(const u32x4*)(Kp + (size_t)((t) * 64 + row_) * kpitch + ch_ * 8); } \
        _Pragma("unroll") for (int i_ = 0; i_ < VPT; ++i_) { const int c_ = tid + 512 * i_; const int d_ = c_ >> 3, ch_ = c_ & 7; \
            vreg[i_] = *(const u32x4*)(Vtp + (size_t)d_ * VTP + (t) * 64 + ch_ * 8); } } while (0)
#define AT_LWRITE(buf) do { LAS unsigned char* kb_ = lds + (buf) * BUF; \
        _Pragma("unroll") for (int i_ = 0; i_ < KPT; ++i_) { const int c_ = tid + 512 * i_; const int row_ = c_ / CPR, ch_ = c_ % CPR; *(LAS u32x4*)(kb_ + row_ * KROW + ch_ * 16) = kreg[i_]; } \
        _Pragma("unroll") for (int i_ = 0; i_ < VPT; ++i_) { const int c_ = tid + 512 * i_; const int d_ = c_ >> 3, ch_ = c_ & 7; LAS unsigned char* vp_ = kb_ + KT_BYTES + d_ * VROW + ch_ * 16; \
            *(LAS u32x2*)(vp_) = (u32x2){vreg[i_].x, vreg[i_].y}; *(LAS u32x2*)(vp_ + 8) = (u32x2){vreg[i_].z, vreg[i_].w}; } } while (0)
    const int t_first = (MODE == 0) ? t_hi : t_lo, t_last = (MODE == 0) ? t_lo : t_hi, dt = (MODE == 0) ? -1 : 1;
    float cq0u = 0.f, cq0w = 0.f;
    if (MODE == 0) { cq0u = Cfp[qb * 256]; cq0w = Cfp[q0w]; }
    AT_GLOAD(t_first); AT_LWRITE(0);
    __syncthreads();
    for (int t = t_first, it_ = 0; ; t += dt, ++it_) {
        const int buf = it_ & 1;
        bool more = (t != t_last);
        if (MODE == 0 && more) { const int tn = t - 1; if (64 * tn + 63 < qb * 256) { if (b2x2 + cq0u - Cfp[64 * tn + 63] < -150.f) more = false; } }
        if (more) AT_GLOAD(t + dt);
        bool active = (64 * t <= q0w + 31);
        if (MODE == 2) active = active && (64 * t + 63 > q0w - 128);
        if (MODE == 0) { if (64 * t + 63 < q0w) { if (b2x2 + cq0w - Cfp[64 * t + 63] < -150.f) active = false; } }
        if (active) {
            const LAS unsigned char* kb = lds + buf * BUF; const LAS unsigned char* vb = kb + KT_BYTES;
            f32x16 st[2];
            {
                bf16x8 ka[NSTEP], kc[NSTEP];
#pragma unroll
                for (int s = 0; s < NSTEP; ++s) ka[s] = *(const LAS bf16x8*)(kb + l31 * KROW + s * 32 + hh * 16);
                __builtin_amdgcn_sched_barrier(0);
                if (MODE == 0) {
#pragma unroll
                    for (int blk = 0; blk < 2; ++blk)
#pragma unroll
                        for (int g4 = 0; g4 < 4; ++g4) { const f32x4 nck = *(const f32x4*)(Ncp + t * 64 + 32 * blk + 8 * g4 + 4 * hh);
#pragma unroll
                            for (int e = 0; e < 4; ++e) st[blk][4 * g4 + e] = nck[e]; }
                } else {
                    const float c0_ = (MODE == 1) ? -b2x2 : 0.f;
#pragma unroll
                    for (int r = 0; r < 16; ++r) { st[0][r] = c0_; st[1][r] = c0_; }
                }
#pragma unroll
                for (int s = 0; s < NSTEP; ++s) { kc[s] = *(const LAS bf16x8*)(kb + (32 + l31) * KROW + s * 32 + hh * 16);
                    st[0] = __builtin_amdgcn_mfma_f32_32x32x16_bf16(ka[s], qf[s], st[0], 0, 0, 0); }
                __builtin_amdgcn_sched_barrier(0);
#pragma unroll
                for (int s = 0; s < NSTEP; ++s) st[1] = __builtin_amdgcn_mfma_f32_32x32x16_bf16(kc[s], qf[s], st[1], 0, 0, 0);
            }
            unsigned wlo = 0u, whi = 0u;
            if (MODE == 1) { const u64 mw = Mp[(size_t)qg * 32 + t] >> (4 * hh); wlo = (unsigned)mw; whi = (unsigned)(mw >> 32); }
            if (MODE != 1) {
                bool need = (64 * t + 63 > q0w);
                if (MODE == 2) need = need || (64 * t <= q0w + 31 - 128);
                if (need) {
#pragma unroll
                    for (int blk = 0; blk < 2; ++blk)
#pragma unroll
                        for (int r = 0; r < 16; ++r) { const int key = 64 * t + 32 * blk + 8 * (r >> 2) + 4 * hh + (r & 3);
                            bool bad = key > qg; if (MODE == 2) bad = bad || (key <= qg - 128);
                            if (bad) st[blk][r] = -INFINITY; }
                }
            }
            float ps = 0.f;
            if (MODE == 1) {
#pragma unroll
                for (int blk = 0; blk < 2; ++blk) { const unsigned wd = blk ? whi : wlo;
#pragma unroll
                    for (int r = 0; r < 16; ++r) { const int bit = 8 * (r >> 2) + (r & 3); int sel; asm("v_bfe_i32 %0, %1, %2, 1" : "=v"(sel) : "v"(wd), "n"(bit));
                        const float p = __int_as_float(__float_as_int(__builtin_amdgcn_exp2f(st[blk][r])) & sel); st[blk][r] = p; ps += p; } }
                l += ps;
            } else {
                float mt = st[0][0];
#pragma unroll
                for (int r = 1; r < 16; ++r) mt = fmaxf(mt, st[0][r]);
#pragma unroll
                for (int r = 0; r < 16; ++r) mt = fmaxf(mt, st[1][r]);
                mt = fmaxf(mt, __shfl_xor(mt, 32));
                const float mn = fmaxf(m, mt);
                const float ms = (mn == -INFINITY) ? 0.f : mn;
                const float alpha = __builtin_amdgcn_exp2f(m - ms);
                m = mn;
                st[0] = st[0] - ms; st[1] = st[1] - ms;
#pragma unroll
                for (int blk = 0; blk < 2; ++blk)
#pragma unroll
                    for (int r = 0; r < 16; ++r) { const float p = __builtin_amdgcn_exp2f(st[blk][r]); st[blk][r] = p; ps += p; }
                l = l * alpha + ps;
                if (!__all(alpha == 1.0f)) {
#pragma unroll
                    for (int d = 0; d < NDB; ++d)
#pragma unroll
                        for (int r = 0; r < 16; ++r) o[d][r] *= alpha;
                }
            }
            bf16x8 pf[2][2];
#pragma unroll
            for (int blk = 0; blk < 2; ++blk)
#pragma unroll
                for (int s = 0; s < 2; ++s) { u32x4 pw; pw.x = pg8::cvt_pk_bf16(st[blk][8 * s + 0], st[blk][8 * s + 1]); pw.y = pg8::cvt_pk_bf16(st[blk][8 * s + 2], st[blk][8 * s + 3]);
                    pw.z = pg8::cvt_pk_bf16(st[blk][8 * s + 4], st[blk][8 * s + 5]); pw.w = pg8::cvt_pk_bf16(st[blk][8 * s + 6], st[blk][8 * s + 7]); pf[blk][s] = __builtin_bit_cast(bf16x8, pw); }
            {
#pragma unroll
                for (int dp = 0; dp < NDB; dp += 2) {
                    u32x4 vf[2][2][2];
#pragma unroll
                    for (int d2 = 0; d2 < 2; ++d2)
#pragma unroll
                        for (int blk = 0; blk < 2; ++blk)
#pragma unroll
                            for (int s = 0; s < 2; ++s) { const LAS unsigned char* vp = vb + (32 * (dp + d2) + l31) * VROW + (32 * blk + 16 * s + 4 * hh) * 2;
                                const u32x2 v0 = *(const LAS u32x2*)(vp), v1 = *(const LAS u32x2*)(vp + 16); vf[d2][blk][s] = (u32x4){v0.x, v0.y, v1.x, v1.y}; }
                    __builtin_amdgcn_sched_barrier(0);
#pragma unroll
                    for (int d2 = 0; d2 < 2; ++d2)
#pragma unroll
                        for (int blk = 0; blk < 2; ++blk)
#pragma unroll
                            for (int s = 0; s < 2; ++s) o[dp + d2] = __builtin_amdgcn_mfma_f32_32x32x16_bf16(__builtin_bit_cast(bf16x8, vf[d2][blk][s]), pf[blk][s], o[dp + d2], 0, 0, 0);
                    __builtin_amdgcn_sched_barrier(0);
                }
            }
        }
        if (more) AT_LWRITE(buf ^ 1);
        __syncthreads();
        if (!more) break;
    }
#undef AT_GLOAD
#undef AT_LWRITE
    if (MODE == 1 && chunk >= 0) {
        float* mine = part + (size_t)chunk * (8 * (NDB * 16 + 2) * 64); float* other = part + (size_t)(chunk ^ 1) * (8 * (NDB * 16 + 2) * 64);
        gu64* pw = (gu64*)(mine + (size_t)w * (NDB * 16 + 2) * 64) + lane;
#pragma unroll
        for (int d = 0; d < NDB; ++d)
#pragma unroll
            for (int r = 0; r < 16; r += 2) __hip_atomic_store(pw + (d * 8 + (r >> 1)) * 64, (u64)__float_as_uint(o[d][r]) | ((u64)__float_as_uint(o[d][r + 1]) << 32), __ATOMIC_RELAXED, __HIP_MEMORY_SCOPE_AGENT);
        __hip_atomic_store(pw + (NDB * 8) * 64, (u64)__float_as_uint(m) | ((u64)__float_as_uint(l) << 32), __ATOMIC_RELAXED, __HIP_MEMORY_SCOPE_AGENT);
        asm volatile("s_waitcnt vmcnt(0)" ::: "memory");
        __syncthreads();
        if (tid == 0) {
            const unsigned old_ = __hip_atomic_fetch_add(pcnt, 1u, __ATOMIC_RELAXED, __HIP_MEMORY_SCOPE_AGENT);
            if (old_ != 0u) { __builtin_amdgcn_fence(__ATOMIC_ACQUIRE, "agent"); asm volatile("s_waitcnt vmcnt(0)" ::: "memory"); }
            bc[1] = (int)old_;
        }
        __syncthreads();
        const int arrived = bc[1];
        if (arrived == 0) return;
        const u64* po = (const u64*)(other + (size_t)w * (NDB * 16 + 2) * 64) + lane;
        const u64 ml2 = po[(NDB * 8) * 64];
        const float m2 = __uint_as_float((unsigned)ml2), l2 = __uint_as_float((unsigned)(ml2 >> 32));
        const float mt = fmaxf(m, m2), ms = (mt == -INFINITY) ? 0.f : mt;
        const float fa = __builtin_amdgcn_exp2f(m - ms), fb = __builtin_amdgcn_exp2f(m2 - ms);
        l = l * fa + l2 * fb;
#pragma unroll
        for (int d = 0; d < NDB; ++d)
#pragma unroll
            for (int r = 0; r < 16; r += 2) { const u64 v2 = po[(d * 8 + (r >> 1)) * 64];
                o[d][r] = o[d][r] * fa + __uint_as_float((unsigned)v2) * fb; o[d][r + 1] = o[d][r + 1] * fa + __uint_as_float((unsigned)(v2 >> 32)) * fb; }
    }
    l += __shfl_xor(l, 32);
    const float inv = 1.f / l;
#pragma unroll
    for (int db = 0; db < NDB; ++db)
#pragma unroll
        for (int g4 = 0; g4 < 4; ++g4) { const int d0 = 32 * db + 8 * g4 + 4 * hh;
            const u32x2 gw = *(const u32x2*)(Gp + (size_t)qg * gpitch + d0);
            const float g0 = bf2f((unsigned short)(gw.x & 0xffffu)), g1 = bf2f((unsigned short)(gw.x >> 16)), g2 = bf2f((unsigned short)(gw.y & 0xffffu)), g3 = bf2f((unsigned short)(gw.y >> 16));
            const float y0 = o[db][4 * g4 + 0] * inv * (g0 / (1.f + __expf(-g0))), y1 = o[db][4 * g4 + 1] * inv * (g1 / (1.f + __expf(-g1)));
            const float y2 = o[db][4 * g4 + 2] * inv * (g2 / (1.f + __expf(-g2))), y3 = o[db][4 * g4 + 3] * inv * (g3 / (1.f + __expf(-g3)));
            u32x2 yw; yw.x = pk2(y0, y1); yw.y = pk2(y2, y3);
            *(u32x2*)(Yp + (size_t)qg * DM + d0) = yw; }
}


__device__ __forceinline__ void swa_unit(LAS unsigned char* lds, const bf16_t* hb, const bf16_t* Vtp, bf16_t* Yb, const float* sinks, const float* gsw, int kvh, int j) {
    constexpr int KROW = 144, VROW = 136, KT = 64 * KROW, VTB = 64 * VROW, V_OFF = 4 * KT;
    const int tid = tid_fresh(), lane = tid & 63, w = __builtin_amdgcn_readfirstlane(tid >> 6), l31 = lane & 31, hh = lane >> 5;
    const int rg = w & 3, hg = w >> 2, t0 = 2 * j - 2;
    {
        u32x4 kr[4], vr[4];
#pragma unroll
        for (int i = 0; i < 4; ++i) { const int cc = tid, row = cc >> 3, ch = cc & 7, t = t0 + i;
            kr[i] = (u32x4){0u, 0u, 0u, 0u}; vr[i] = kr[i];
            if (t >= 0) { kr[i] = *(const u32x4*)(hb + C1_K + kvh * 64 + (size_t)(t * 64 + row) * N1 + ch * 8); vr[i] = *(const u32x4*)(Vtp + (size_t)row * VTP + t * 64 + ch * 8); } }
#pragma unroll
        for (int i = 0; i < 4; ++i) { const int cc = tid, row = cc >> 3, ch = cc & 7;
            *(LAS u32x4*)(lds + i * KT + row * KROW + ch * 16) = kr[i];
            LAS unsigned char* vp = lds + V_OFF + i * VTB + row * VROW + ch * 16;
            *(LAS u32x2*)(vp) = (u32x2){vr[i].x, vr[i].y}; *(LAS u32x2*)(vp + 8) = (u32x2){vr[i].z, vr[i].w}; }
    }
    __syncthreads();
    const int q0w = 128 * j + 32 * rg, qg = q0w + l31;
    float mref;
    { float gq = fabsf(gsw[lane]), gk = fabsf(gsw[64 + lane]);
#pragma unroll
      for (int o_ = 1; o_ < 64; o_ <<= 1) { gq = fmaxf(gq, __shfl_xor(gq, o_)); gk = fmaxf(gk, __shfl_xor(gk, o_)); }
      mref = fminf(11.6f * gq * gk, 60.f); }
    bf16x8 qn[4];
#pragma unroll
    for (int s = 0; s < 4; ++s) qn[s] = *(const bf16x8*)(hb + C1_Q + (kvh * 8 + hg * 4) * 64 + (size_t)qg * N1 + 16 * s + 8 * hh);
    for (int hi = 0; hi < 4; ++hi) {
        const int hq = kvh * 8 + hg * 4 + hi;
        bf16x8 qf[4];
#pragma unroll
        for (int s = 0; s < 4; ++s) qf[s] = qn[s];
        if (hi < 3) {
#pragma unroll
            for (int s = 0; s < 4; ++s) qn[s] = *(const bf16x8*)(hb + C1_Q + (hq + 1) * 64 + (size_t)qg * N1 + 16 * s + 8 * hh);
        }
        u32x2 gq[8];
#pragma unroll
        for (int i = 0; i < 8; ++i) gq[i] = *(const u32x2*)(hb + C1_G + hq * 64 + (size_t)qg * N1 + 32 * (i >> 2) + 8 * (i & 3) + 4 * hh);
        f32x16 o[2];
#pragma unroll
        for (int d = 0; d < 2; ++d)
#pragma unroll
            for (int r = 0; r < 16; ++r) o[d][r] = 0.f;
        float l = (hh == 0) ? __builtin_amdgcn_exp2f(sinks[hq] * LOG2E - mref) : 0.f;
        for (int sl = 0; sl < 4; ++sl) {
            const int t = t0 + sl;
            if (t < 0) continue;
            if (!((64 * t <= q0w + 31) && (64 * t + 63 > q0w - 128))) continue;
            const LAS unsigned char* kb = lds + sl * KT; const LAS unsigned char* vb = lds + V_OFF + sl * VTB;
            f32x16 st[2];
            {
                bf16x8 ka[4], kc[4];
#pragma unroll
                for (int s = 0; s < 4; ++s) ka[s] = *(const LAS bf16x8*)(kb + l31 * KROW + s * 32 + hh * 16);
#pragma unroll
                for (int s = 0; s < 4; ++s) kc[s] = *(const LAS bf16x8*)(kb + (32 + l31) * KROW + s * 32 + hh * 16);
#pragma unroll
                for (int r = 0; r < 16; ++r) { st[0][r] = -mref; st[1][r] = -mref; }
#pragma unroll
                for (int s = 0; s < 4; ++s) st[0] = __builtin_amdgcn_mfma_f32_32x32x16_bf16(ka[s], qf[s], st[0], 0, 0, 0);
#pragma unroll
                for (int s = 0; s < 4; ++s) st[1] = __builtin_amdgcn_mfma_f32_32x32x16_bf16(kc[s], qf[s], st[1], 0, 0, 0);
            }
            u64 mw = ~0ull;
            if ((64 * t + 63 > q0w) || (64 * t <= q0w + 31 - 128)) {
                const int hi_ = qg - 64 * t, lo_ = qg - 127 - 64 * t;
                const u64 mhi = (hi_ < 0) ? 0ull : ((hi_ >= 63) ? ~0ull : ((2ull << hi_) - 1ull));
                const u64 mlo = (lo_ <= 0) ? ~0ull : ((lo_ > 63) ? 0ull : ~((1ull << lo_) - 1ull));
                mw = mhi & mlo;
            }
            mw >>= (4 * hh);
            const unsigned wlo = (unsigned)mw, whi = (unsigned)(mw >> 32);
            float ps = 0.f;
#pragma unroll
            for (int blk = 0; blk < 2; ++blk) { const unsigned wd = blk ? whi : wlo;
#pragma unroll
                for (int r = 0; r < 16; ++r) { const int bit = 8 * (r >> 2) + (r & 3); int sel; asm("v_bfe_i32 %0, %1, %2, 1" : "=v"(sel) : "v"(wd), "n"(bit));
                    const float p = __int_as_float(__float_as_int(__builtin_amdgcn_exp2f(st[blk][r])) & sel); st[blk][r] = p; ps += p; } }
            l += ps;
            bf16x8 pf[2][2];
#pragma unroll
            for (int blk = 0; blk < 2; ++blk)
#pragma unroll
                for (int s = 0; s < 2; ++s) { u32x4 pw; pw.x = pg8::cvt_pk_bf16(st[blk][8 * s + 0], st[blk][8 * s + 1]); pw.y = pg8::cvt_pk_bf16(st[blk][8 * s + 2], st[blk][8 * s + 3]);
                    pw.z = pg8::cvt_pk_bf16(st[blk][8 * s + 4], st[blk][8 * s + 5]); pw.w = pg8::cvt_pk_bf16(st[blk][8 * s + 6], st[blk][8 * s + 7]); pf[blk][s] = __builtin_bit_cast(bf16x8, pw); }
            {
                u32x4 vf[2][2][2];
#pragma unroll
                for (int d2 = 0; d2 < 2; ++d2)
#pragma unroll
                    for (int blk = 0; blk < 2; ++blk)
#pragma unroll
                        for (int s = 0; s < 2; ++s) { const LAS unsigned char* vp = vb + (32 * d2 + l31) * VROW + (32 * blk + 16 * s + 4 * hh) * 2;
                            const u32x2 v0 = *(const LAS u32x2*)(vp), v1 = *(const LAS u32x2*)(vp + 16); vf[d2][blk][s] = (u32x4){v0.x, v0.y, v1.x, v1.y}; }
#pragma unroll
                for (int d2 = 0; d2 < 2; ++d2)
#pragma unroll
                    for (int blk = 0; blk < 2; ++blk)
#pragma unroll
                        for (int s = 0; s < 2; ++s) o[d2] = __builtin_amdgcn_mfma_f32_32x32x16_bf16(__builtin_bit_cast(bf16x8, vf[d2][blk][s]), pf[blk][s], o[d2], 0, 0, 0);
            }
        }
        l += __shfl_xor(l, 32);
        const float inv = 1.f / l;
#pragma unroll
        for (int db = 0; db < 2; ++db)
#pragma unroll
            for (int g4 = 0; g4 < 4; ++g4) { const int d0 = 32 * db + 8 * g4 + 4 * hh;
                const u32x2 gw = gq[db * 4 + g4];
                const float g0 = bf2f((unsigned short)(gw.x & 0xffffu)), g1 = bf2f((unsigned short)(gw.x >> 16)), g2 = bf2f((unsigned short)(gw.y & 0xffffu)), g3 = bf2f((unsigned short)(gw.y >> 16));
                const float y0 = o[db][4 * g4 + 0] * inv * (g0 / (1.f + __expf(-g0))), y1 = o[db][4 * g4 + 1] * inv * (g1 / (1.f + __expf(-g1)));
                const float y2 = o[db][4 * g4 + 2] * inv * (g2 / (1.f + __expf(-g2))), y3 = o[db][4 * g4 + 3] * inv * (g3 / (1.f + __expf(-g3)));
                u32x2 yw; yw.x = pk2(y0, y1); yw.y = pk2(y2, y3);
                *(u32x2*)(Yb + (size_t)qg * DM + hq * 64 + d0) = yw; }
    }
    __syncthreads();
}

__device__ __forceinline__ void idx_unit(LAS unsigned char* lds, const bf16_t* H, const float* SIDE, u64* MASK, int b, int u) {
    const int tid = tid_fresh(), lane = tid & 63, w = __builtin_amdgcn_readfirstlane(tid >> 6), l31 = lane & 31, hh = lane >> 5;
    LAS unsigned* sc = (LAS unsigned*)lds;
    const int q0 = 16 * u + 2 * w;
    const int qi = l31 >> 4, head = l31 & 15;
    const bf16_t* iqp = H + (size_t)(b * SEQ + q0 + qi) * N0 + C_IQ + head * 64 + 8 * hh;
    bf16x8 aq[4];
#pragma unroll
    for (int s = 0; s < 4; ++s) aq[s] = *(const bf16x8*)(iqp + 16 * s);
    float w0[8], w1[8];
#pragma unroll
    for (int r = 0; r < 8; ++r) { const int hd = (r & 3) + 8 * (r >> 2) + 4 * hh;
        w0[r] = SIDE[(size_t)(b * SEQ + q0) * 256 + 72 + hd] * 0.03125f; w1[r] = SIDE[(size_t)(b * SEQ + q0 + 1) * 256 + 72 + hd] * 0.03125f; }
    const int ngrp = (16 * u + 15) / 128 + 1;
    LAS unsigned char* ikb = lds + LDS_IK_OFF;
    const bf16_t* ikg = H + (size_t)(b * SEQ) * N0 + C_IK;
    u32x4 pre[2];
#pragma unroll
    for (int i = 0; i < 2; ++i) { const int c = tid + 512 * i; pre[i] = *(const u32x4*)(ikg + (size_t)(c >> 3) * N0 + (c & 7) * 8); }
    for (int prs_ = 0; prs_ < ((PROBE_IDX == 1) ? 3 : 1); ++prs_)
    for (int g = 0; g < ngrp; ++g) {
        if (prs_ > 0 && g == 0) {
#pragma unroll
            for (int i = 0; i < 2; ++i) { const int c = tid + 512 * i; pre[i] = *(const u32x4*)(ikg + (size_t)(c >> 3) * N0 + (c & 7) * 8); } }
        __syncthreads();
#pragma unroll
        for (int i = 0; i < 2; ++i) { const int c = tid + 512 * i; *(LAS u32x4*)(ikb + (c >> 3) * 144 + (c & 7) * 16) = pre[i]; }
        __syncthreads();
        if (g + 1 < ngrp) {
#pragma unroll
            for (int i = 0; i < 2; ++i) { const int c = tid + 512 * i; pre[i] = *(const u32x4*)(ikg + (size_t)(128 * (g + 1) + (c >> 3)) * N0 + (c & 7) * 8); }
        }
#pragma unroll
        for (int kb = 0; kb < 4; ++kb) {
            f32x16 c;
#pragma unroll
            for (int r = 0; r < 16; ++r) c[r] = 0.f;
#pragma unroll
            for (int s = 0; s < 4; ++s) { const bf16x8 bk = *(const LAS bf16x8*)(ikb + (32 * kb + l31) * 144 + 32 * s + 16 * hh);
                c = __builtin_amdgcn_mfma_f32_32x32x16_bf16(aq[s], bk, c, 0, 0, 0); }
            float s0 = 0.f, s1 = 0.f;
#pragma unroll
            for (int r = 0; r < 8; ++r) { s0 += w0[r] * __builtin_amdgcn_fmed3f(c[r], 0.f, INFINITY); s1 += w1[r] * __builtin_amdgcn_fmed3f(c[8 + r], 0.f, INFINITY); }
            s0 += __shfl_xor(s0, 32); s1 += __shfl_xor(s1, 32);
            const float val = (hh ? s1 : s0) + 0.0f;
            const int key = 128 * g + 32 * kb + l31, qq = q0 + hh;
            unsigned uv = __float_as_uint(val); uv ^= (uv >> 31) ? 0xffffffffu : 0x80000000u;
            sc[(2 * w + hh) * 2048 + key] = (key <= qq) ? uv : 0u;
        }
    }
    LDS_WAIT(); asm volatile("" ::: "memory");
    const u64 lt = (1ull << lane) - 1ull;
    for (int prq_ = 0; prq_ < ((PROBE_IDX == 2) ? 3 : 1); ++prq_)
    for (int rr = 0; rr < 2; ++rr) {
        const int row = 2 * w + rr, qq = 16 * u + row;
        unsigned kv[32];
#pragma unroll
        for (int i = 0; i < 32; ++i) { const int idx = 64 * i + lane; kv[i] = (idx <= qq) ? sc[row * 2048 + idx] : 0u; }
        unsigned T = 0u;
        const int nblk8 = (qq >> 9) + 1;
        if (qq + 1 > 256) {
            for (int bit = 31; bit >= 0; --bit) {
                const unsigned cand = T | (1u << bit); int c = 0;
#pragma unroll
                for (int blk = 0; blk < 4; ++blk) if (blk < nblk8) {
#pragma unroll
                    for (int j = 0; j < 8; ++j) c += (kv[8 * blk + j] >= cand) ? 1 : 0;
                }
                u64 bm[6];
#pragma unroll
                for (int bb = 0; bb < 6; ++bb) bm[bb] = __ballot((c >> bb) & 1);
                int cnt = 0;
#pragma unroll
                for (int bb = 0; bb < 6; ++bb) cnt += __popcll(bm[bb]) << bb;
                if (cnt >= 256) T = cand;
                if (cnt == 256) break;
            }
        }
        int cgt = 0;
#pragma unroll
        for (int blk = 0; blk < 4; ++blk) {
            u64 mm[8];
#pragma unroll
            for (int j = 0; j < 8; ++j) mm[j] = __ballot(kv[8 * blk + j] > T);
#pragma unroll
            for (int j = 0; j < 8; ++j) cgt += __popcll(mm[j]);
        }
        const int need = (T == 0u) ? 0 : 256 - cgt;
        int running = 0; u64 myword = 0ull;
#pragma unroll
        for (int i = 0; i < 32; ++i) { const bool eq = (kv[i] == T); const u64 em = __ballot(eq); const int rank = running + __popcll(em & lt);
            const bool sel = (kv[i] > T) || (eq && rank < need); const u64 word = __ballot(sel); if (lane == i) myword = word; running += __popcll(em); }
        if (lane < 32) __hip_atomic_store((gu64*)(MASK + ((size_t)b * SEQ + qq) * 32 + lane), myword, __ATOMIC_RELAXED, __HIP_MEMORY_SCOPE_AGENT);
    }
}

#define XB_TMO      128
#define XB_XCNT(j)  (256  + 64 * (j))
#define XB_XSUB(j)  (1280 + 64 * (j))
#define XB_XGEN(j)  (2304 + 64 * (j))
#define XB_TOP      3328
#define XB_TOPGEN   3392
#define XCD_BAR_WORDS 3456
#define XB_SPIN_CAP (1u << 18)

__device__ __forceinline__ unsigned xb_ld(unsigned* p)              { return __hip_atomic_load(p, __ATOMIC_RELAXED, __HIP_MEMORY_SCOPE_AGENT); }
__device__ __forceinline__ unsigned xb_add(unsigned* p, unsigned v) { return __hip_atomic_fetch_add(p, v, __ATOMIC_RELAXED, __HIP_MEMORY_SCOPE_AGENT); }
__device__ __forceinline__ unsigned xb_xcc_id() { return (unsigned)__builtin_amdgcn_s_getreg((3 << 11) | 20) & 0xFu; }
#define XB_SPIN(cond, bar) do { unsigned _sp = 0; while (cond) { __builtin_amdgcn_s_sleep(1); \
    if ((++_sp & 255u) == 0u) { if (xb_ld(&(bar)[XB_TMO])) break; if (_sp > XB_SPIN_CAP) { atomicAdd(&(bar)[XB_TMO], 1u); break; } } } } while (0)

struct XcdBarrier {
    unsigned* bar; unsigned x;
    volatile LAS unsigned* st;
};

__device__ __forceinline__ XcdBarrier xcd_barrier_post(unsigned* bar, volatile LAS unsigned* st) {
    XcdBarrier b; b.bar = bar; b.x = xb_xcc_id(); b.st = st;
    if (threadIdx.x == 0) (void)xb_add(&bar[XB_XCNT(b.x)], 1u);
    return b;
}
__device__ __forceinline__ void xcd_barrier_complete(unsigned* bar, unsigned x, unsigned& nloc, unsigned& nx) {
    const unsigned G = gridDim.x * gridDim.y * gridDim.z;
    unsigned sum, cnt, mine, sp = 0u;
    for (;;) {
        sum = 0u; cnt = 0u; mine = 0u;
#pragma unroll
        for (unsigned j = 0; j < 16; ++j) { const unsigned c = xb_ld(&bar[XB_XCNT(j)]); sum += c; cnt += (c > 0u) ? 1u : 0u; mine = (j == x) ? c : mine; }
        if (sum == G) break;
        __builtin_amdgcn_s_sleep(1);
        if ((++sp & 255u) == 0u) { if (xb_ld(&bar[XB_TMO])) break; if (sp > XB_SPIN_CAP) { atomicAdd(&bar[XB_TMO], 1u); break; } }
    }
    nloc = mine > 0u ? mine : 1u; nx = cnt > 0u ? cnt : 1u;
}

__device__ __forceinline__ void xcd_barrier(const XcdBarrier& b) {
    asm volatile("s_waitcnt vmcnt(0)" ::: "memory");
    __syncthreads();
    if (threadIdx.x == 0) {
        unsigned* bar = b.bar;
        __builtin_amdgcn_s_waitcnt(0);
        unsigned nloc = b.st[0], nx = b.st[1];
        if (nloc == 0u) { xcd_barrier_complete(bar, b.x, nloc, nx); b.st[0] = nloc; b.st[1] = nx; }
        const unsigned old = xb_add(&bar[XB_XSUB(b.x)], 1u);
        const unsigned gen = old / nloc;
        if (old + 1u == (gen + 1u) * nloc) {
            __builtin_amdgcn_fence(__ATOMIC_RELEASE, "agent");
            asm volatile("s_waitcnt vmcnt(0)" ::: "memory");
            const unsigned og = xb_add(&bar[XB_TOP], 1u);
            const unsigned tg = og / nx;
            if (og + 1u == (tg + 1u) * nx) xb_add(&bar[XB_TOPGEN], 1u);
            else XB_SPIN(xb_ld(&bar[XB_TOPGEN]) == tg, bar);
            __builtin_amdgcn_fence(__ATOMIC_ACQUIRE, "agent");
            xb_add(&bar[XB_XGEN(b.x)], 1u);
            asm volatile("s_waitcnt vmcnt(0)" ::: "memory");
        } else {
            XB_SPIN(xb_ld(&bar[XB_XGEN(b.x)]) == gen, bar);
            __builtin_amdgcn_fence(__ATOMIC_ACQUIRE, "agent");
            asm volatile("s_waitcnt vmcnt(0)" ::: "memory");
        }
    }
    __syncthreads();
}

struct Params { const float* in[13]; float* out; unsigned char* ws; };


typedef const __attribute__((address_space(4))) Params* KParams;
__device__ __forceinline__ KParams kparams() { KParams p = (KParams)__builtin_amdgcn_kernarg_segment_ptr(); asm volatile("" : "+s"(p)); return p; }
#define PHASE_PTRS() KParams pp_ = kparams(); \
    const int tid = tid_fresh(), lane = tid & 63, wave = __builtin_amdgcn_readfirstlane(tid >> 6); const int G = gridDim.x, bx = blockIdx.x; const int gw = bx * 8 + wave, NGW = G * 8; \
    (void)lane; (void)gw; (void)NGW; \
    const float* x = pp_->in[0]; const float* norm_even = pp_->in[1]; const float* w_in_even = pp_->in[2]; const float* b_f = pp_->in[3]; \
    const float* g_fox = pp_->in[4]; const float* g_dsa = pp_->in[5]; const float* g_kidx = pp_->in[6]; const float* w_out_even = pp_->in[7]; \
    const float* norm_odd = pp_->in[8]; const float* w_in_odd = pp_->in[9]; const float* g_swa = pp_->in[10]; const float* sinks = pp_->in[11]; const float* w_out_odd = pp_->in[12]; \
    unsigned char* ws = pp_->ws; float* out = pp_->out; \
    unsigned* ctl = (unsigned*)(ws + WS_CTL); \
    bf16_t* WT0 = (bf16_t*)(ws + WS_WT0); bf16_t* WO0 = (bf16_t*)(ws + WS_WO0); bf16_t* WT1 = (bf16_t*)(ws + WS_WT1); bf16_t* WO1 = (bf16_t*)(ws + WS_WO1); \
    bf16_t* ACT = (bf16_t*)(ws + WS_ACT); bf16_t* H = (bf16_t*)(ws + WS_H); bf16_t* VT = (bf16_t*)(ws + WS_VT); \
    float* ROPE = (float*)(ws + WS_ROPE); float* SS = (float*)(ws + WS_SS); bf16_t* XG = VT; bf16_t* VT1 = H + (size_t)NTOK * N1; (void)SS; (void)XG; (void)VT1; \
    float* SIDE = (float*)((unsigned char*)out + DO_SIDE); float* CF = (float*)((unsigned char*)out + DO_CF); u64* MASK = (u64*)((unsigned char*)out + DO_MASK); \
    (void)x; (void)norm_even; (void)w_in_even; (void)b_f; (void)g_fox; (void)g_dsa; (void)g_kidx; (void)w_out_even; (void)norm_odd; (void)w_in_odd; (void)g_swa; (void)sinks; (void)w_out_odd; \
    (void)ctl; (void)WT0; (void)WO0; (void)WT1; (void)WO1; (void)ACT; (void)H; (void)VT; (void)ROPE; (void)SIDE; (void)CF; (void)MASK;

__global__ void __launch_bounds__(512, 2) fwd_megakernel(Params P) {
    extern __shared__ __attribute__((aligned(16))) unsigned char lds_raw[];
    LAS unsigned char* lds = (LAS unsigned char*)lds_raw;
    volatile LAS int* lctl = (volatile LAS int*)(lds + LDS_CTL_OFF);
    cg::grid_group grid = cg::this_grid();
    if (threadIdx.x < 64) lctl[threadIdx.x] = 0;
    __syncthreads();
    XcdBarrier xbar;
    { KParams pq_ = kparams(); xbar = xcd_barrier_post((unsigned*)(pq_->ws + WS_BAR), (volatile LAS unsigned*)(lctl + 8)); }
    if (gridDim.x == 0x7fffffffu) grid.sync();
#define GRID_SYNC() xcd_barrier(xbar)
    for (int rep_ = 0; rep_ < REP(0); ++rep_) {
    {
        PHASE_PTRS();
        LAS float* scr = (LAS float*)(lds + wave * 8448);
        constexpr int I0 = 32 * (N0T / 32);
        for (int it = gw; it < I0; it += NGW) p0_transpose_item(w_in_even, EVEN_IN, 0, WT0, scr, it, N0T / 32, lane);
        for (int mrow = gw; mrow < NTOK; mrow += NGW) rms_row_to_bf16(x + (size_t)mrow * DM, norm_even, ACT + (size_t)mrow * DM, lane);
        if (bx == 0 && tid < 96) {
            const int j = tid;
            const double ex = (j < 64) ? (double)(2 * j) / 128.0 : (double)(2 * (j - 64)) / 64.0;
            ROPE[j] = (float)(exp2(-ex * 13.287712379549449) * 0.15915494309189535);
        }
    }
    GRID_SYNC();
    }
    for (int rep_ = 0; rep_ < REP(1); ++rep_) {
    {
        PHASE_PTRS();
        pg8::Gemm g{ACT, WT0, NTOK, N0, DM}; pg8::StaticOrder S; S.init(NTOK, N0, G, bx);
        pg8::EpiProj E{H, N0, SIDE, N0 / 256 - 1, nullptr, 0, 0, g_fox, g_dsa, g_kidx, ROPE, (LAS float*)(lds + LDS_XCH_OFF), 0.08838834764831845f * LOG2E};
        if (PROBE_PLAIN && rep_ < REP(1) - 1) { pg8::EpiBf16 Ep{H, N0, SIDE, N0 / 256 - 1, nullptr, 0}; pg8::gemm_phase<pg8::EpiBf16, pg8::StaticOrder, true, true>(lds, g, S, Ep); }
        else pg8::gemm_phase<pg8::EpiProj, pg8::StaticOrder, true, true>(lds, g, S, E);
        pg8::Gemm g2{WT0 + (size_t)N0 * DM, ACT, 2048, NTOK, DM}; pg8::StaticOrder S2; S2.init(2048, NTOK, G, bx);
        pg8::EpiBf16 E2{VT, VTP, nullptr, -1, nullptr, 0};
        pg8::gemm_phase<pg8::EpiBf16, pg8::StaticOrder, true, true>(lds, g2, S2, E2);
        if ((G == 256) ? (bx >= 160) : true) {
            constexpr int IO = 32 * (DM / 32), I1 = 32 * (N1T / 32);
            const int nw_ = (G == 256) ? 96 * 8 : NGW, w0_ = (G == 256) ? (bx - 160) * 8 + wave : gw;
            LAS float* scr = (LAS float*)(lds + wave * 8448);
            __syncthreads();
            for (int it = w0_; it < IO + I1; it += nw_) {
                if (it < IO) p0_transpose_item(w_out_even, DM, 2, WO0, scr, it, DM / 32, lane);
                else p0_transpose_item(w_in_odd, ODD_IN, 1, WT1, scr, it - IO, N1T / 32, lane);
            }
        }
    }
    GRID_SYNC();
    }
    for (int rep_ = 0; rep_ < REP(3); ++rep_) {
    {
        PHASE_PTRS();
    for (;;) {
        __syncthreads();
        if (tid == 0) lctl[0] = (int)atomicAdd(&ctl[0 + rep_], 1u);
        __syncthreads();
        const int it = lctl[0];
        if (it >= 768 + 384) break;
        if (it >= 512 && it < 896) {
            const int id = it - 512, k12 = id >> 5, bh = id & 31, b = bh >> 3, h = bh & 7;
            const int qb = (int)((0x405162776543ULL >> (4 * k12)) & 15ULL);
            const int chunk = (k12 == 0 || k12 == 6 || k12 == 8 || k12 == 10) ? -1 : ((k12 >= 1 && k12 <= 4) ? 0 : 1);
            if (tid == 0) {
                unsigned sp_ = 0;
                while (__hip_atomic_load(ctl + 192 + b * 8 + qb, __ATOMIC_RELAXED, __HIP_MEMORY_SCOPE_AGENT) < 16u) { __builtin_amdgcn_s_sleep(4); if (++sp_ > (1u << 22)) break; }
                __builtin_amdgcn_fence(__ATOMIC_ACQUIRE, "agent"); asm volatile("s_waitcnt vmcnt(0)" ::: "memory");
            }
            __syncthreads();
            const bf16_t* hb = H + (size_t)b * SEQ * N0;
            float mref;
            { float gq = fmaxf(fabsf(g_dsa[lane]), fabsf(g_dsa[64 + lane])), gk = fmaxf(fabsf(g_dsa[128 + lane]), fabsf(g_dsa[192 + lane]));
#pragma unroll
              for (int o_ = 1; o_ < 64; o_ <<= 1) { gq = fmaxf(gq, __shfl_xor(gq, o_)); gk = fmaxf(gk, __shfl_xor(gk, o_)); }
              mref = fminf(16.5f * gq * gk, 60.f); }
            float* part = (float*)((unsigned char*)out + DO_PART) + (size_t)((bh * 4 + (qb & 3)) * 2) * (8 * 66 * 64);
            attn_unit<128, 1>(lds, hb + C_DQ + h * 128, N0, hb + C_DK + h * 128, N0, VT + (size_t)(1024 + h * 128) * VTP + b * SEQ, hb + C_DG + h * 128, N0,
                              ACT + (size_t)b * SEQ * DM + 1024 + h * 128, nullptr, MASK + (size_t)b * SEQ * 32, 0.f, mref, qb, chunk, part, ctl + 64 + bh * 4 + (qb & 3), lctl);
        } else if (it >= 896) {
            const int if_ = it - 896; const int qb = 7 - (if_ >> 5), bh = if_ & 31, b = bh >> 3, h = bh & 7;
            const bf16_t* hb = H + (size_t)b * SEQ * N0;
            LAS float* c2 = (LAS float*)(lds + 73728); LAS float* wtot = c2 + 2048;
            {
                const int nrows = (qb + 1) * 256; const float bias = b_f[h];
                float v4[4] = {0.f, 0.f, 0.f, 0.f}, run = 0.f;
                if (4 * tid < nrows) {
                    float fv[4];
#pragma unroll
                    for (int e = 0; e < 4; ++e) fv[e] = SIDE[(size_t)(b * SEQ + 4 * tid + e) * 256 + 64 + h];
#pragma unroll
                    for (int e = 0; e < 4; ++e) { const float f = fv[e] + bias; run += (fminf(f, 0.f) - log1pf(expf(-fabsf(f)))) * LOG2E; v4[e] = run; }
                }
                float incl = run;
#pragma unroll
                for (int o = 1; o < 64; o <<= 1) { const float tt = __shfl_up(incl, o); if (lane >= o) incl += tt; }
                if (lane == 63) wtot[wave] = incl;
                if (wave == 0) {
                    float gq = fmaxf(fabsf(g_fox[lane]), fabsf(g_fox[64 + lane])), gk = fmaxf(fabsf(g_fox[128 + lane]), fabsf(g_fox[192 + lane]));
#pragma unroll
                    for (int o = 1; o < 64; o <<= 1) { gq = fmaxf(gq, __shfl_xor(gq, o)); gk = fmaxf(gk, __shfl_xor(gk, o)); }
                    if (lane == 0) wtot[8] = 33.0f * gq * gk;
                }
                __syncthreads();
                float pre = incl - run;
                for (int w_ = 0; w_ < wave; ++w_) pre += wtot[w_];
                if (4 * tid < nrows) { const f32x4 cv = {v4[0] + pre, v4[1] + pre, v4[2] + pre, v4[3] + pre}; *(LAS f32x4*)(c2 + 4 * tid) = cv; *(LAS f32x4*)(c2 + 2304 + 4 * tid) = -cv; }
                __syncthreads();
            }
            attn_unit<128, 0>(lds, hb + C_FQ + h * 128, N0, hb + C_FK + h * 128, N0, VT + (size_t)(h * 128) * VTP + b * SEQ, hb + C_FG + h * 128, N0,
                              ACT + (size_t)b * SEQ * DM + h * 128, (const float*)c2, nullptr, 0.f, wtot[8], qb, -1, nullptr, nullptr, nullptr, (const float*)(c2 + 2304));
        } else {
            const int j = it, u = 127 - (j >> 2), b = j & 3;
            idx_unit(lds, H, SIDE, MASK, b, u);
            asm volatile("s_waitcnt vmcnt(0)" ::: "memory");
            __syncthreads();
            if (tid == 0) __hip_atomic_fetch_add(ctl + 192 + b * 8 + (u >> 4), 1u, __ATOMIC_RELAXED, __HIP_MEMORY_SCOPE_AGENT);
        }
    }
    }
    GRID_SYNC();
    }
    {
        PHASE_PTRS();
        pg8::Gemm g{ACT, WO0, NTOK, DM, DM}; pg8::StaticOrder S; S.init(NTOK, DM, G, bx);
        for (int rep_ = 0; rep_ < REP(5); ++rep_) {
        pg8::EpiResXg E{x, out, DM, norm_odd, XG, (rep_ < REP(5) - 1) ? (float*)H : SS};
        pg8::gemm_phase<pg8::EpiResXg, pg8::StaticOrder, true, true>(lds, g, S, E);
        if (rep_ < REP(5) - 1) GRID_SYNC();
        }
    }
    GRID_SYNC();
    for (int rep_ = 0; rep_ < REP(7); ++rep_) {
    {
        PHASE_PTRS();
        pg8::Gemm g{XG, WT1, NTOK, N1, DM}; pg8::StaticOrder S; S.init(NTOK, N1, G, bx);
        pg8::EpiProj E{H, N1, nullptr, -1, SS, 1, 1, g_swa, nullptr, nullptr, ROPE, (LAS float*)(lds + LDS_XCH_OFF), 0.125f * LOG2E};
        pg8::gemm_phase<pg8::EpiProj, pg8::StaticOrder, true, true>(lds, g, S, E);
        pg8::Gemm g2{WT1 + (size_t)N1 * DM, XG, 256, NTOK, DM}; pg8::StaticOrder S2; S2.init(256, NTOK, G, (bx + G - 64) % G);
        pg8::EpiBf16 E2{VT1, VTP, nullptr, -1, SS, 2};
        pg8::gemm_phase<pg8::EpiBf16, pg8::StaticOrder, true, true>(lds, g2, S2, E2);
        {
            constexpr int IO = 32 * (DM / 32);
            const bool mine_ = (G == 256) ? (bx >= 96) : true;
            const int nw_ = (G == 256) ? 160 * 8 : NGW, w0_ = (G == 256) ? (bx - 96) * 8 + wave : gw;
            LAS float* scr = (LAS float*)(lds + wave * 8448);
            __syncthreads();
            if (mine_) for (int it = w0_; it < IO; it += nw_) p0_transpose_item(w_out_odd, DM, 2, WO1, scr, it, DM / 32, lane);
        }
    }
    GRID_SYNC();
    }
    for (int rep_ = 0; rep_ < REP(9); ++rep_) {
    {
        PHASE_PTRS();
    for (int it = bx; it < NB * 4 * 16; it += G) {
        const int j = it & 15, kvh = (it >> 4) & 3, b = it >> 6;
        swa_unit(lds, H + (size_t)b * SEQ * N1, VT1 + (size_t)(kvh * 64) * VTP + b * SEQ, ACT + (size_t)b * SEQ * DM, sinks, g_swa, kvh, j);
    }
    }
    GRID_SYNC();
    }
    for (int es_ = 0; es_ < PROBE_SYNCS; ++es_) GRID_SYNC();
    {
        PHASE_PTRS();
        pg8::Gemm g{ACT, WO1, NTOK, DM, DM}; pg8::StaticOrder S; S.init(NTOK, DM, G, bx);
        for (int rep_ = 0; rep_ < REP(10); ++rep_) {
        pg8::EpiResF32 E{out, (rep_ < REP(10) - 1) ? (float*)H : out, DM};
        pg8::gemm_phase<pg8::EpiResF32, pg8::StaticOrder, true, true>(lds, g, S, E);
        if (rep_ < REP(10) - 1) GRID_SYNC();
        }
    }
}

extern "C" void kernel_launch(void* const* d_in, const int* in_sizes, int n_in, void* d_out, int out_size, void* d_ws, size_t ws_size, hipStream_t stream) {
    static int grid = 0;
    if (grid == 0) {
        if (n_in != 13 || out_size != NTOK * DM || ws_size < WS_END) { fprintf(stderr, "kernel_launch: unexpected shapes (n_in %d, out %d, ws %zu need %zu)\n", n_in, out_size, ws_size, (size_t)WS_END); grid = -1; return; }
        int dev = 0, cus = 0, per_cu = 0;
        hipGetDevice(&dev);
        hipDeviceGetAttribute(&cus, hipDeviceAttributeMultiprocessorCount, dev);
        hipFuncSetAttribute((const void*)fwd_megakernel, hipFuncAttributeMaxDynamicSharedMemorySize, LDS_BYTES);
        hipOccupancyMaxActiveBlocksPerMultiprocessor(&per_cu, (const void*)fwd_megakernel, 512, LDS_BYTES);
        if (per_cu < 1) per_cu = 1;
        if (per_cu > 1) per_cu = 1;
        (void)hipGetLastError();
        grid = cus * per_cu;
    }
    if (grid < 0) return;
    if (hipMemsetAsync((char*)d_ws + WS_CTL, 0, CTL_BYTES, stream) != hipSuccess) { fprintf(stderr, "kernel_launch: memset failed\n"); return; }
    Params p{};
    for (int i = 0; i < 13; ++i) p.in[i] = (const float*)d_in[i];
    p.out = (float*)d_out; p.ws = (unsigned char*)d_ws;
    void* args[] = {&p};
    hipError_t e = hipLaunchCooperativeKernel((const void*)fwd_megakernel, dim3(grid), dim3(512), args, LDS_BYTES, stream);
    if (e != hipSuccess) fprintf(stderr, "cooperative launch failed: %s (grid %d)\n", hipGetErrorString(e), grid);
}
```

```cpp
#include <hip/hip_runtime.h>
#include <hip/hip_cooperative_groups.h>
#include <cstdio>
#include <cstdint>
namespace cg = cooperative_groups;
namespace pg8 {
#define PG8_LAS __attribute__((address_space(3)))
typedef unsigned short bf16_t;
typedef short bf16x8 __attribute__((ext_vector_type(8)));
typedef float f32x4 __attribute__((ext_vector_type(4)));
typedef unsigned u32x4 __attribute__((ext_vector_type(4)));
constexpr int BM = 256, BK = 64, HALF = 128, HTB = HALF * BK * 2  , STAGE_BYTES = 8 * HTB, NXCD = 8, WGM = 8;

__host__ __device__ __forceinline__ int lds_byte(int r, int c) { const int st = (r >> 4) * 2 + (c >> 5), rr = r & 15, cc = c & 31, ob = rr * 64 + cc * 2; return st * 1024 + (ob ^ (((ob >> 9) & 1) << 5)); }
__host__ __device__ __forceinline__ void stage_rc(int b, int& R, int& C) { const int st = b / 1024, sb = b % 1024, swz = sb ^ (((sb >> 9) & 1) << 5); R = (st >> 1) * 16 + swz / 64; C = (st & 1) * 32 + (swz % 64) / 2; }
__host__ __device__ __forceinline__ int perm32(int rho) { const int n = rho >> 4, i = rho & 15; return 8 * (i >> 2) + 4 * n + (i & 3); }

struct Unit { int pm, pn; };
struct Gemm { const bf16_t* A; const bf16_t* Bt; int M, N, K; };

struct StaticOrder {
    int nM, nN, nwg, G, c;
    __host__ __device__ void init(int M, int N, int G_, int c_) { nM = M / BM; nN = N / BM; nwg = nM * nN; G = G_; c = c_; }
    __host__ __device__ bool next(int i, Unit& u) const {
        const long L = (long)i * G + c; if (L >= nwg) return false;
        int wgid = (int)L; { const int q = nwg / NXCD, r = nwg % NXCD, xcd = wgid % NXCD, off = wgid / NXCD; wgid = (xcd < r ? xcd * (q + 1) : r * (q + 1) + (xcd - r) * q) + off; }
        const int nig = WGM * nN, gid = wgid / nig, fm = gid * WGM, gsz = (nM - fm) < WGM ? (nM - fm) : WGM;
        u.pm = fm + ((wgid % nig) % gsz); u.pn = (wgid % nig) / gsz; return true;
    }
    __device__ __forceinline__ void a_ready(const Unit&) const {}
    __device__ __forceinline__ void done(const Unit&) const {}
};

typedef float f32x2v __attribute__((ext_vector_type(2)));
typedef __bf16 bf16x2v __attribute__((ext_vector_type(2)));
__device__ __forceinline__ unsigned cvt_pk_bf16(float lo, float hi) { f32x2v v = {lo, hi}; bf16x2v b = __builtin_convertvector(v, bf16x2v); return __builtin_bit_cast(unsigned, b); }

struct EpiBf16 {
    static constexpr bool PERM = true, AFTER_DRAIN = false;
    bf16_t* O; int ldc; float* side; int side_pn; const float* ss; int smode;
    __device__ __forceinline__ void operator()(const f32x4 (&acc)[2][2][4][2], const Unit& u, int wr, int wc, int fr, int fq) const {
        const int row0 = u.pm * BM + wr * 64 + fr; const int colt = u.pn * BM;
        const int col0 = colt + wc * 32 + 8 * fq;
#pragma unroll
        for (int ai = 0; ai < 2; ++ai)
#pragma unroll
            for (int m = 0; m < 4; ++m) { bf16_t* rowp = O + (size_t)(row0 + ai * HALF + m * 16) * ldc + col0;
#pragma unroll
                for (int bj = 0; bj < 2; ++bj) { f32x4 v0 = acc[ai][bj][m][0], v1 = acc[ai][bj][m][1];
                    if (smode == 1) { const float rs = 1.f / sqrtf(ss[row0 + ai * HALF + m * 16] * (1.f / 2048.f) + 1e-6f); v0 = v0 * rs; v1 = v1 * rs; }
                    else if (smode == 2) { const f32x4 s0 = *(const f32x4*)(ss + col0 + bj * HALF), s1 = *(const f32x4*)(ss + col0 + bj * HALF + 4);
#pragma unroll
                        for (int e = 0; e < 4; ++e) { v0[e] *= 1.f / sqrtf(s0[e] * (1.f / 2048.f) + 1e-6f); v1[e] *= 1.f / sqrtf(s1[e] * (1.f / 2048.f) + 1e-6f); } }
                    u32x4 w; w.x = cvt_pk_bf16(v0[0], v0[1]); w.y = cvt_pk_bf16(v0[2], v0[3]); w.z = cvt_pk_bf16(v1[0], v1[1]); w.w = cvt_pk_bf16(v1[2], v1[3]);
                    *(u32x4*)(rowp + bj * HALF) = w; } }
        if (side != nullptr && u.pn == side_pn) {
#pragma unroll
            for (int ai = 0; ai < 2; ++ai)
#pragma unroll
                for (int m = 0; m < 4; ++m) { float* sp = side + (size_t)(row0 + ai * HALF + m * 16) * 256 + wc * 32 + 8 * fq;
#pragma unroll
                    for (int bj = 0; bj < 2; ++bj) { *(f32x4*)(sp + bj * HALF) = acc[ai][bj][m][0]; *(f32x4*)(sp + bj * HALF + 4) = acc[ai][bj][m][1]; } }
        }
    }
};
struct EpiResF32 {
    static constexpr bool PERM = false, AFTER_DRAIN = false;
    const float* base; float* out; int ldc;
    __device__ __forceinline__ void operator()(const f32x4 (&acc)[2][2][4][2], const Unit& u, int wr, int wc, int fr, int fq) const {
        const int col0 = u.pn * BM + wc * 32 + 4 * fq;
#pragma unroll
        for (int ai = 0; ai < 2; ++ai)
#pragma unroll
            for (int m = 0; m < 4; ++m) { const size_t off = (size_t)(u.pm * BM + ai * HALF + wr * 64 + m * 16 + fr) * ldc + col0;
#pragma unroll
                for (int bj = 0; bj < 2; ++bj)
#pragma unroll
                    for (int n = 0; n < 2; ++n) { const f32x4 bs = *(const f32x4*)(base + off + bj * HALF + n * 16); *(f32x4*)(out + off + bj * HALF + n * 16) = bs + acc[ai][bj][m][n]; } }
    }
};

struct EpiResXg {
    static constexpr bool PERM = false, AFTER_DRAIN = false;
    const float* base; float* out; int ldc; const float* gain; bf16_t* xg; float* ss;
    __device__ __forceinline__ void operator()(const f32x4 (&acc)[2][2][4][2], const Unit& u, int wr, int wc, int fr, int fq) const {
        const int col0 = u.pn * BM + wc * 32 + 4 * fq;
        f32x4 gv[2][2];
#pragma unroll
        for (int bj = 0; bj < 2; ++bj)
#pragma unroll
            for (int n = 0; n < 2; ++n) gv[bj][n] = *(const f32x4*)(gain + col0 + bj * HALF + n * 16);
#pragma unroll
        for (int ai = 0; ai < 2; ++ai)
#pragma unroll
            for (int m = 0; m < 4; ++m) { const int row = u.pm * BM + ai * HALF + wr * 64 + m * 16 + fr; const size_t off = (size_t)row * ldc + col0; float part = 0.f;
#pragma unroll
                for (int bj = 0; bj < 2; ++bj)
#pragma unroll
                    for (int n = 0; n < 2; ++n) { const f32x4 x1 = *(const f32x4*)(base + off + bj * HALF + n * 16) + acc[ai][bj][m][n];
                        *(f32x4*)(out + off + bj * HALF + n * 16) = x1; part += (x1[0] * x1[0] + x1[1] * x1[1]) + (x1[2] * x1[2] + x1[3] * x1[3]);
                        const f32x4 y = x1 * gv[bj][n]; unsigned long long pk = (unsigned long long)cvt_pk_bf16(y[0], y[1]) | ((unsigned long long)cvt_pk_bf16(y[2], y[3]) << 32);
                        *(unsigned long long*)(xg + off + bj * HALF + n * 16) = pk; }
                part += __shfl_xor(part, 16); part += __shfl_xor(part, 32);
                if (fq == 0) atomicAdd(ss + row, part); }
    }
};

struct HalfDesc { int type; const float* gain; int rope; float scale; int plain_hi; };
struct EpiProj {
    static constexpr bool PERM = true, AFTER_DRAIN = false;
    bf16_t* O; int ldc; float* side; int side_pn; const float* ss; int smode; int layer;
    const float* ga; const float* gb; const float* gc; const float* rope; PG8_LAS float* xch; float qs;
    __device__ __forceinline__ HalfDesc desc(int ht) const {
        if (layer == 0) {
            if (ht < 8)  return HalfDesc{1, ga, -1, qs, 0};
            if (ht < 16) return HalfDesc{1, ga + 128, -1, 1.f, 0};
            if (ht < 24) return HalfDesc{0, nullptr, -1, 1.f, 0};
            if (ht < 32) return HalfDesc{1, gb, 0, qs, 0};
            if (ht < 40) return HalfDesc{1, gb + 128, 0, 1.f, 0};
            if (ht < 48) return HalfDesc{0, nullptr, -1, 1.f, 0};
            if (ht < 56) return HalfDesc{2, nullptr, 64, 1.f, 0};
            if (ht == 56) return HalfDesc{2, gc, 64, 1.f, 1};
            return HalfDesc{0, nullptr, -1, 1.f, 0};
        }
        if (ht < 16) return HalfDesc{2, ga, 64, qs, 0};
        if (ht < 18) return HalfDesc{2, ga + 64, 64, 1.f, 0};
        return HalfDesc{0, nullptr, -1, 1.f, 0};
    }
    __device__ __forceinline__ void operator()(f32x4 (&acc)[2][2][4][2], const Unit& u, int wr, int wc, int fr, int fq) const {
        const int row0 = u.pm * BM + wr * 64 + fr; const int col0 = u.pn * BM + wc * 32 + 8 * fq;
        const HalfDesc d0 = desc(2 * u.pn), d1 = desc(2 * u.pn + 1);
        if (smode == 1) {
#pragma unroll
            for (int ai = 0; ai < 2; ++ai)
#pragma unroll
                for (int m = 0; m < 4; ++m) { const float rs = 1.f / sqrtf(ss[row0 + ai * HALF + m * 16] * (1.f / 2048.f) + 1e-6f);
#pragma unroll
                    for (int bj = 0; bj < 2; ++bj) { acc[ai][bj][m][0] = acc[ai][bj][m][0] * rs; acc[ai][bj][m][1] = acc[ai][bj][m][1] * rs; } }
        }
        const bool nx0 = (d0.type != 0) && (d0.gain != nullptr), nx1 = (d1.type != 0) && (d1.gain != nullptr);
        if (nx0 || nx1) {
#pragma unroll
            for (int ai = 0; ai < 2; ++ai)
#pragma unroll
                for (int m = 0; m < 4; ++m)
#pragma unroll
                    for (int bj = 0; bj < 2; ++bj) { if (bj == 0 ? nx0 : nx1) { const f32x4 a0 = acc[ai][bj][m][0], a1 = acc[ai][bj][m][1];
                        float p = ((a0[0] * a0[0] + a0[1] * a0[1]) + (a0[2] * a0[2] + a0[3] * a0[3])) + ((a1[0] * a1[0] + a1[1] * a1[1]) + (a1[2] * a1[2] + a1[3] * a1[3]));
                        p += __shfl_xor(p, 16); p += __shfl_xor(p, 32);
                        if (fq == 0) xch[((ai * HALF + wr * 64 + m * 16 + fr) * 2 + bj) * 4 + wc] = p; } }
            asm volatile("s_waitcnt lgkmcnt(0)" ::: "memory"); __builtin_amdgcn_s_barrier(); asm volatile("" ::: "memory");
        }
        bool act[2], nrm[2], rpo[2]; int hdv[2]; f32x4 gA[2], gB[2], fQ[2];
#pragma unroll
        for (int bj = 0; bj < 2; ++bj) { const HalfDesc d = bj ? d1 : d0;
            act[bj] = d.type != 0 && !(d.plain_hi && wc >= 2); nrm[bj] = act[bj] && d.gain != nullptr; rpo[bj] = act[bj] && d.rope >= 0; hdv[bj] = (d.type == 1) ? 128 : 64;
            const int g = (d.type == 1) ? 4 * wc + fq : 4 * (wc & 1) + fq; const int i0 = (d.rope >= 0) ? 4 * g : 8 * g, i1 = (d.rope >= 0) ? hdv[bj] / 2 + 4 * g : 8 * g + 4;
            gA[bj] = (f32x4){1.f, 1.f, 1.f, 1.f}; gB[bj] = gA[bj]; fQ[bj] = (f32x4){0.f, 0.f, 0.f, 0.f};
            if (nrm[bj]) { gA[bj] = *(const f32x4*)(d.gain + i0) * d.scale; gB[bj] = *(const f32x4*)(d.gain + i1) * d.scale; }
            if (rpo[bj]) fQ[bj] = *(const f32x4*)(rope + d.rope + 4 * g); }
#pragma unroll
        for (int ai = 0; ai < 2; ++ai)
#pragma unroll
            for (int m = 0; m < 4; ++m) { const int row = row0 + ai * HALF + m * 16; bf16_t* rowp = O + (size_t)row * ldc + col0; const float sf = (float)(row & 2047);
#pragma unroll
                for (int bj = 0; bj < 2; ++bj) { const HalfDesc d = bj ? d1 : d0; f32x4 v0 = acc[ai][bj][m][0], v1 = acc[ai][bj][m][1];
                    if (act[bj]) {
                        const int hd = hdv[bj];
                        const bool rp_on = rpo[bj];
                        if (nrm[bj]) { const PG8_LAS float* xp = xch + ((ai * HALF + wr * 64 + m * 16 + fr) * 2 + bj) * 4;
                            const float tot = (d.type == 1) ? ((xp[0] + xp[1]) + (xp[2] + xp[3])) : (xp[wc & 2] + xp[(wc & 2) + 1]);
                            const float r = __builtin_amdgcn_rsqf(tot * (1.f / (float)hd) + 1e-6f);
                            v0 = v0 * (gA[bj] * r); v1 = v1 * (gB[bj] * r); }
                        if (rp_on) { const f32x4 fq4 = fQ[bj];
                            f32x4 c, sn;
#pragma unroll
                            for (int e = 0; e < 4; ++e) { const float rv = __builtin_amdgcn_fractf(sf * fq4[e]); c[e] = __builtin_amdgcn_cosf(rv); sn[e] = __builtin_amdgcn_sinf(rv); }
                            const f32x4 o0 = v0 * c - v1 * sn, o1 = v0 * sn + v1 * c; v0 = o0; v1 = o1; }
                    }
                    u32x4 w; w.x = cvt_pk_bf16(v0[0], v0[1]); w.y = cvt_pk_bf16(v0[2], v0[3]); w.z = cvt_pk_bf16(v1[0], v1[1]); w.w = cvt_pk_bf16(v1[2], v1[3]);
                    *(u32x4*)(rowp + bj * HALF) = w; } }
        if (side != nullptr && u.pn == side_pn) {
#pragma unroll
            for (int ai = 0; ai < 2; ++ai)
#pragma unroll
                for (int m = 0; m < 4; ++m) { float* sp = side + (size_t)(row0 + ai * HALF + m * 16) * 256 + wc * 32 + 8 * fq;
#pragma unroll
                    for (int bj = 0; bj < 2; ++bj) { *(f32x4*)(sp + bj * HALF) = acc[ai][bj][m][0]; *(f32x4*)(sp + bj * HALF + 4) = acc[ai][bj][m][1]; } }
        }
    }
};

template <class Epi, class Sched, bool ALIGN_EPI = false, bool SP2 = false>
__device__ __forceinline__ void gemm_phase(PG8_LAS unsigned char* lds, const Gemm g, const Sched& S, const Epi& E) {
    int tid_ = threadIdx.x; asm volatile("" : "+v"(tid_)); const int tid = tid_, wid = __builtin_amdgcn_readfirstlane(tid >> 6), lane = tid & 63, wr = wid >> 2, wc = wid & 3, fr = lane & 15, fq = lane >> 4;
    const int K = g.K, nt = K / BK;
    unsigned voffA[2], voffB[2];
#pragma unroll
    for (int i = 0; i < 2; ++i) { int R, C; stage_rc(tid * 16 + i * 8192, R, C); const int Rb = Epi::PERM ? ((R & ~31) + perm32(R & 31)) : R;
        voffA[i] = (unsigned)(R * K + C) * 2u; voffB[i] = (unsigned)(Rb * K + C) * 2u; }
    const size_t kstep = (size_t)(BK * 2);
    const size_t hstep = (size_t)HALF * K * 2;
    const size_t tstep = 2 * hstep;
    const unsigned ldsw = (unsigned)wid * 1024u;
    const int aoff = lds_byte(wr * 64 + fr, fq * 8), boff = lds_byte(wc * 32 + fr, fq * 8);
#define PG8_SA(b, h) (((b) * 2 + (h)) * HTB)
#define PG8_SB(b, h) ((4 + (b) * 2 + (h)) * HTB)
#define PG8_STAGE(bufoff, gbase, voff) do { _Pragma("unroll") for (int _i = 0; _i < 2; ++_i) \
        __builtin_amdgcn_global_load_lds((const unsigned*)((const char*)(gbase) + (voff)[_i]), (PG8_LAS unsigned*)(lds + (bufoff) + ldsw + _i * 8192), 16, 0, 0); } while (0)
#define PG8_LDA(dst, b, h) do { _Pragma("unroll") for (int m = 0; m < 4; ++m) _Pragma("unroll") for (int k = 0; k < 2; ++k) dst[m][k] = *(const PG8_LAS bf16x8*)(lds + PG8_SA(b, h) + aoff + m * 2048 + k * 1024); } while (0)
#define PG8_LDB(dst, b, h) do { _Pragma("unroll") for (int n = 0; n < 2; ++n) _Pragma("unroll") for (int k = 0; k < 2; ++k) dst[n][k] = *(const PG8_LAS bf16x8*)(lds + PG8_SB(b, h) + boff + n * 2048 + k * 1024); } while (0)
#define PG8_MMA(ai, bj, At, Bt) do { __builtin_amdgcn_s_setprio(1); _Pragma("unroll") for (int m = 0; m < 4; ++m) _Pragma("unroll") for (int n = 0; n < 2; ++n) _Pragma("unroll") for (int k = 0; k < 2; ++k) \
        acc[ai][bj][m][n] = __builtin_amdgcn_mfma_f32_16x16x32_bf16(Bt[n][k], At[m][k], acc[ai][bj][m][n], 0, 0, 0); __builtin_amdgcn_s_setprio(0); } while (0)
#define PG8_WAIT_V(n) asm volatile("s_waitcnt vmcnt(" #n ")" ::: "memory")
#define PG8_WAIT_L(n) asm volatile("s_waitcnt lgkmcnt(" #n ")" ::: "memory")
#define PG8_BAR __builtin_amdgcn_s_barrier()
#define PG8_SCHED __builtin_amdgcn_sched_barrier(0)
    Unit cur, nxt; int ui = 0;
    if (!S.next(0, cur)) return;
    f32x4 acc[2][2][4][2];
#pragma unroll
    for (int a = 0; a < 2; ++a)
#pragma unroll
        for (int b = 0; b < 2; ++b)
#pragma unroll
            for (int m = 0; m < 4; ++m)
#pragma unroll
                for (int n = 0; n < 2; ++n) acc[a][b][m][n] = (f32x4){0.f, 0.f, 0.f, 0.f};
    bf16x8 At[4][2], B0[2][2], B1[2][2];
    const char* cA = (const char*)g.A + (size_t)cur.pm * tstep; const char* cB = (const char*)g.Bt + (size_t)cur.pn * tstep;
    S.a_ready(cur);
    if constexpr (SP2) {
        PG8_STAGE(PG8_SB(0, 0), cB, voffB); PG8_STAGE(PG8_SB(0, 1), cB + hstep, voffB); PG8_STAGE(PG8_SA(0, 0), cA, voffA); PG8_STAGE(PG8_SA(0, 1), cA + hstep, voffA);
        if (wr == 1) PG8_BAR;
        PG8_WAIT_V(2); PG8_BAR;
        PG8_STAGE(PG8_SB(1, 0), cB + kstep, voffB); PG8_STAGE(PG8_SA(1, 0), cA + kstep, voffA); PG8_STAGE(PG8_SB(1, 1), cB + hstep + kstep, voffB);
        PG8_WAIT_V(6); PG8_BAR;
    } else {
        PG8_STAGE(PG8_SB(0, 0), cB, voffB); PG8_STAGE(PG8_SA(0, 0), cA, voffA); PG8_STAGE(PG8_SB(0, 1), cB + hstep, voffB); PG8_STAGE(PG8_SA(0, 1), cA + hstep, voffA);
        if (wr == 1) PG8_BAR;
        PG8_WAIT_V(4); PG8_BAR;
        PG8_STAGE(PG8_SB(1, 0), cB + kstep, voffB); PG8_STAGE(PG8_SA(1, 0), cA + kstep, voffA); PG8_STAGE(PG8_SB(1, 1), cB + hstep + kstep, voffB);
        PG8_WAIT_V(6); PG8_BAR;
    }
    for (;;) {
        const bool has_next = S.next(ui + 1, nxt);
        const char* nA = has_next ? (const char*)g.A + (size_t)nxt.pm * tstep : cA; const char* nB = has_next ? (const char*)g.Bt + (size_t)nxt.pn * tstep : cB;
        for (int t = 0; t < nt; t += 2) {
            const bool last = (t == nt - 2);
            const char* a1 = cA + (size_t)(t + 1) * kstep;
            const char* a2 = last ? nA : cA + (size_t)(t + 2) * kstep; const char* b2 = last ? nB : cB + (size_t)(t + 2) * kstep;
            const char* a3 = a2 + kstep; const char* b3 = b2 + kstep;
            if (last && has_next) S.a_ready(nxt);
            if constexpr (SP2) {
            PG8_LDB(B0, 0, 0); PG8_LDB(B1, 0, 1); PG8_SCHED; PG8_LDA(At, 0, 0); PG8_STAGE(PG8_SA(1, 1), a1 + hstep, voffA);
            PG8_WAIT_V(8); PG8_WAIT_L(0); PG8_BAR; PG8_MMA(0, 0, At, B0); PG8_MMA(0, 1, At, B1); PG8_BAR; PG8_SCHED;
            PG8_LDA(At, 0, 1); PG8_STAGE(PG8_SB(0, 0), b2, voffB); PG8_STAGE(PG8_SB(0, 1), b2 + hstep, voffB); PG8_STAGE(PG8_SA(0, 0), a2, voffA);
            PG8_WAIT_V(8); PG8_WAIT_L(0); PG8_BAR; PG8_MMA(1, 0, At, B0); PG8_MMA(1, 1, At, B1); PG8_BAR; PG8_SCHED;
            PG8_LDB(B0, 1, 0); PG8_LDB(B1, 1, 1); PG8_SCHED; PG8_LDA(At, 1, 0); PG8_STAGE(PG8_SA(0, 1), a2 + hstep, voffA);
            PG8_WAIT_V(8); PG8_WAIT_L(0); PG8_BAR; PG8_MMA(0, 0, At, B0); PG8_MMA(0, 1, At, B1); PG8_BAR; PG8_SCHED;
            PG8_LDA(At, 1, 1); PG8_STAGE(PG8_SB(1, 0), b3, voffB); PG8_STAGE(PG8_SB(1, 1), b3 + hstep, voffB); PG8_STAGE(PG8_SA(1, 0), a3, voffA);
            PG8_WAIT_V(8); PG8_WAIT_L(0); PG8_BAR; PG8_MMA(1, 0, At, B0); PG8_MMA(1, 1, At, B1); PG8_BAR; PG8_SCHED;
            } else {
            PG8_LDB(B0, 0, 0); PG8_SCHED; PG8_LDA(At, 0, 0); PG8_STAGE(PG8_SA(1, 1), a1 + hstep, voffA);
            PG8_WAIT_L(8); PG8_BAR; PG8_WAIT_L(0); PG8_MMA(0, 0, At, B0); PG8_BAR; PG8_SCHED;
            PG8_LDB(B1, 0, 1); PG8_STAGE(PG8_SB(0, 0), b2, voffB);
            PG8_BAR; PG8_WAIT_L(0); PG8_MMA(0, 1, At, B1); PG8_BAR;
            PG8_LDA(At, 0, 1); PG8_STAGE(PG8_SA(0, 0), a2, voffA);
            PG8_BAR; PG8_WAIT_L(0); PG8_MMA(1, 0, At, B0); PG8_BAR; PG8_SCHED;
            PG8_STAGE(PG8_SB(0, 1), b2 + hstep, voffB);
            PG8_WAIT_V(6); PG8_BAR; PG8_MMA(1, 1, At, B1); PG8_BAR;
            PG8_LDB(B0, 1, 0); PG8_SCHED; PG8_LDA(At, 1, 0); PG8_STAGE(PG8_SA(0, 1), a2 + hstep, voffA);
            PG8_WAIT_L(8); PG8_BAR; PG8_WAIT_L(0); PG8_MMA(0, 0, At, B0); PG8_BAR; PG8_SCHED;
            PG8_LDB(B1, 1, 1); PG8_STAGE(PG8_SB(1, 0), b3, voffB);
            PG8_BAR; PG8_WAIT_L(0); PG8_MMA(0, 1, At, B1); PG8_BAR;
            PG8_LDA(At, 1, 1); PG8_STAGE(PG8_SA(1, 0), a3, voffA);
            PG8_BAR; PG8_WAIT_L(0); PG8_MMA(1, 0, At, B0); PG8_BAR; PG8_SCHED;
            PG8_STAGE(PG8_SB(1, 1), b3 + hstep, voffB);
            PG8_WAIT_V(6); PG8_BAR; PG8_MMA(1, 1, At, B1); PG8_BAR;
            }
        }
        if constexpr (ALIGN_EPI) { if (wr == 0) PG8_BAR; }
        if constexpr (!Epi::AFTER_DRAIN) { E(acc, cur, wr, wc, fr, fq); S.done(cur); }
        if (!has_next) break;
#pragma unroll
        for (int a = 0; a < 2; ++a)
#pragma unroll
            for (int b = 0; b < 2; ++b)
#pragma unroll
                for (int m = 0; m < 4; ++m)
#pragma unroll
                    for (int n = 0; n < 2; ++n) acc[a][b][m][n] = (f32x4){0.f, 0.f, 0.f, 0.f};
        cur = nxt; cA = nA; cB = nB; ++ui;
        if constexpr (ALIGN_EPI) { if (wr == 1) PG8_BAR; }
    }
    PG8_WAIT_V(0);
    if constexpr (!ALIGN_EPI) { if (wr == 0) PG8_BAR; }
    PG8_BAR;
    if constexpr (Epi::AFTER_DRAIN) { E.fused(acc, cur, wr, wc, fr, fq, lds, wid, lane); S.done(cur); }
#undef PG8_SA
#undef PG8_SB
#undef PG8_STAGE
#undef PG8_LDA
#undef PG8_LDB
#undef PG8_MMA
#undef PG8_WAIT_V
#undef PG8_WAIT_L
#undef PG8_BAR
#undef PG8_SCHED
}
}

#ifndef PROBE_DUP
#define PROBE_DUP -1
#endif
#ifndef PROBE_SYNCS
#define PROBE_SYNCS 0
#endif
#ifndef PROBE_PLAIN
#define PROBE_PLAIN 0
#endif
#ifndef PROBE_IDX
#define PROBE_IDX 0
#endif
#ifndef PROBE_P3
#define PROBE_P3 0
#endif
#define REP(k) ((PROBE_DUP == (k)) ? 3 : 1)
#define LAS __attribute__((address_space(3)))
typedef unsigned short bf16_t;
typedef short bf16x8 __attribute__((ext_vector_type(8)));
typedef float f32x4 __attribute__((ext_vector_type(4)));
typedef float f32x16 __attribute__((ext_vector_type(16)));
typedef unsigned u32x4 __attribute__((ext_vector_type(4)));
typedef unsigned u32x2 __attribute__((ext_vector_type(2)));
typedef float f32x2 __attribute__((ext_vector_type(2)));
typedef unsigned long long u64;
typedef __attribute__((address_space(1))) unsigned long long gu64;

constexpr int NB = 4, SEQ = 2048, DM = 2048, NTOK = NB * SEQ;
constexpr int EVEN_IN = 9304, ODD_IN = 4608;
constexpr int N0 = 7424, N0T = 9472;
constexpr int N1 = 4352, N1T = 4608;
constexpr int C_FQ = 0, C_FK = 1024, C_FG = 2048, C_DQ = 3072, C_DK = 4096, C_DG = 5120, C_IQ = 6144, C_IK = 7168;
constexpr int C1_Q = 0, C1_K = 2048, C1_G = 2304;
constexpr float EPS = 1e-6f, LOG2E = 1.4426950408889634f;

constexpr size_t WS_CTL = 0;
constexpr size_t WS_BAR = 4096, WS_SS = 32768, CTL_BYTES = 65536;
constexpr size_t WS_WT0 = CTL_BYTES;
constexpr size_t WS_WO0 = WS_WT0 + (size_t)N0T * DM * 2;
constexpr size_t WS_WT1 = WS_WO0 + (size_t)DM * DM * 2;
constexpr size_t WS_WO1 = WS_WT1 + (size_t)N1T * DM * 2;
constexpr size_t WS_ACT = WS_WO1 + (size_t)DM * DM * 2;
constexpr size_t WS_H   = WS_ACT + (size_t)NTOK * DM * 2;
constexpr size_t WS_VT  = WS_H + (size_t)NTOK * N0 * 2;
constexpr int VTP = NTOK + 128;
constexpr size_t WS_ROPE = WS_VT + (size_t)2048 * VTP * 2;
constexpr size_t WS_END = WS_ROPE + (size_t)SEQ * 192 * 4;
constexpr size_t DO_SIDE = 0;
constexpr size_t DO_CF = DO_SIDE + (size_t)NTOK * 256 * 4;
constexpr size_t DO_MASK = DO_CF + (size_t)NB * 8 * SEQ * 4;
constexpr size_t DO_PART = 16u << 20;

constexpr int LDS_CTL_OFF = 131072;
constexpr int LDS_XCH_OFF = 131072 + 1024;
constexpr int LDS_IK_OFF = 131072 + 1024 + 8192;
constexpr int LDS_BYTES = 131072 + 1024 + 8192 + 18432;

__device__ __forceinline__ float bf2f(unsigned short h) { return __uint_as_float((unsigned)h << 16); }
__device__ __forceinline__ unsigned f2bf(float f) { unsigned u = __float_as_uint(f); return (u + 0x7fffu + ((u >> 16) & 1u)) >> 16; }
__device__ __forceinline__ unsigned pk2(float lo, float hi) { return f2bf(lo) | (f2bf(hi) << 16); }
__device__ __forceinline__ int tid_fresh() { int t = threadIdx.x; asm volatile("" : "+v"(t)); return t; }
#define LDS_WAIT() asm volatile("s_waitcnt lgkmcnt(0)" ::: "memory")

__device__ __forceinline__ int hperm(int p, int hd) { const int g = p >> 3, e = p & 7; return (e < 4) ? 4 * g + e : hd / 2 + 4 * g + (e - 4); }
__device__ __forceinline__ int srccol(int which, int n) {
    if (which == 0) {
        if (n < 2048) return n;
        if (n < 3072) return n + 1024;
        if (n < 4096) { const int r = n - 3072; return 4104 + (r & ~127) + hperm(r & 127, 128); }
        if (n < 5120) { const int r = n - 4096; return 5128 + (r & ~127) + hperm(r & 127, 128); }
        if (n < 6144) return n - 5120 + 7176;
        if (n < 7168) { const int r = n - 6144; return 8200 + (r & ~63) + hperm(r & 63, 64); }
        if (n < 7232) return 9224 + hperm(n - 7168, 64);
        if (n < 7240) return n - 7232 + 4096;
        if (n < 7256) return n - 7240 + 9288;
        if (n < 7424) return -1;
        if (n < 8448) return n - 7424 + 2048;
        return n - 8448 + 6152;
    } else if (which == 1) {
        if (n < 2304) return (n & ~63) + hperm(n & 63, 64);
        if (n < 4352) return n + 256;
        return n - 4352 + 2304;
    }
    return n;
}
__device__ __forceinline__ void p0_transpose_item(const float* W, int N, int which, bf16_t* WT, LAS float* scr, int item, int nblk, int lane) {
    const int kb = item / nblk, nb = item % nblk, k0 = 64 * kb, n0 = 32 * nb;
    const int n4 = lane & 7, kr = lane >> 3;
    const int sc = srccol(which, n0 + 4 * n4);
    f32x4 v[8];
#pragma unroll
    for (int i = 0; i < 8; ++i) v[i] = (sc >= 0) ? *(const f32x4*)(W + (size_t)(k0 + kr + 8 * i) * N + sc) : (f32x4){0.f, 0.f, 0.f, 0.f};
#pragma unroll
    for (int i = 0; i < 8; ++i) { LAS float* d = scr + (kr + 8 * i) * 33 + 4 * n4; d[0] = v[i][0]; d[1] = v[i][1]; d[2] = v[i][2]; d[3] = v[i][3]; }
    LDS_WAIT(); asm volatile("" ::: "memory");
    const int c = lane & 7;
#pragma unroll
    for (int j = 0; j < 4; ++j) { const int n = (lane >> 3) + 8 * j; const LAS float* s = scr + (8 * c) * 33 + n;
        u32x4 o; o.x = pk2(s[0 * 33], s[1 * 33]); o.y = pk2(s[2 * 33], s[3 * 33]); o.z = pk2(s[4 * 33], s[5 * 33]); o.w = pk2(s[6 * 33], s[7 * 33]);
        *(u32x4*)(WT + (size_t)(n0 + n) * DM + k0 + 8 * c) = o; }
    LDS_WAIT(); asm volatile("" ::: "memory");
}
__device__ __forceinline__ float wave_sum(float v) {
#pragma unroll
    for (int o = 1; o < 64; o <<= 1) v += __shfl_xor(v, o);
    return v;
}
__device__ __forceinline__ void rms_row_to_bf16(const float* xrow, const float* g, bf16_t* orow, int lane) {
    const f32x4* xr = (const f32x4*)xrow + lane; const f32x4* gr = (const f32x4*)g + lane;
    f32x4 v[8]; float s = 0.f;
#pragma unroll
    for (int j = 0; j < 8; ++j) { v[j] = xr[64 * j]; s += (v[j].x * v[j].x + v[j].y * v[j].y) + (v[j].z * v[j].z + v[j].w * v[j].w); }
    const float rstd = 1.f / sqrtf(wave_sum(s) * (1.f / DM) + EPS);
    u64* o8 = (u64*)orow + lane;
#pragma unroll
    for (int j = 0; j < 8; ++j) { const f32x4 gg = gr[64 * j];
        o8[64 * j] = (u64)pk2(v[j].x * rstd * gg.x, v[j].y * rstd * gg.y) | ((u64)pk2(v[j].z * rstd * gg.z, v[j].w * rstd * gg.w) << 32); }
}

template <int DIM, bool NORM, bool ROPEF>
__device__ __forceinline__ void pp_kind(bf16_t* Hb, int pitch, int colbase, int nparts_log2, const float* gain, const float* rope, int cs_off, int sn_off, float scale, int gw, int NGW, int lane) {
    constexpr int G = DIM / 4, BATCH = 4;
    const int grp = lane / G, li = lane % G;
    const int total = NTOK << nparts_log2, pmask = (1 << nparts_log2) - 1;
    float g0 = 1.f, g1 = 1.f, g2 = 1.f, g3 = 1.f;
    if (NORM) { g0 = gain[2 * li]; g1 = gain[2 * li + 1]; g2 = gain[DIM / 2 + 2 * li]; g3 = gain[DIM / 2 + 2 * li + 1]; }
    for (int i0 = gw * BATCH; i0 < total; i0 += NGW * BATCH) {
        unsigned a[BATCH], b[BATCH]; bf16_t* hp[BATCH]; f32x2 cv[BATCH], sv[BATCH];
#pragma unroll
        for (int k = 0; k < BATCH; ++k) { const int idx = i0 + k, tok = idx >> nparts_log2, part = idx & pmask;
            hp[k] = Hb + (size_t)tok * pitch + colbase + 256 * part + grp * DIM;
            a[k] = *(const unsigned*)(hp[k] + 2 * li); b[k] = *(const unsigned*)(hp[k] + DIM / 2 + 2 * li);
            if (ROPEF) { const float* rp = rope + (size_t)(tok & (SEQ - 1)) * 192; cv[k] = *(const f32x2*)(rp + cs_off + 2 * li); sv[k] = *(const f32x2*)(rp + sn_off + 2 * li); } }
#pragma unroll
        for (int k = 0; k < BATCH; ++k) {
            float x1a = bf2f((unsigned short)(a[k] & 0xffffu)), x1b = bf2f((unsigned short)(a[k] >> 16)), x2a = bf2f((unsigned short)(b[k] & 0xffffu)), x2b = bf2f((unsigned short)(b[k] >> 16));
            if (NORM) {
                float ss = (x1a * x1a + x1b * x1b) + (x2a * x2a + x2b * x2b);
#pragma unroll
                for (int o = 1; o < G; o <<= 1) ss += __shfl_xor(ss, o);
                const float rstd = 1.f / sqrtf(ss * (1.f / DIM) + EPS);
                x1a *= rstd * g0; x1b *= rstd * g1; x2a *= rstd * g2; x2b *= rstd * g3;
            }
            if (ROPEF) {
                const float c0 = cv[k].x, c1 = cv[k].y, s0 = sv[k].x, s1 = sv[k].y;
                const float o1a = x1a * c0 - x2a * s0, o2a = x1a * s0 + x2a * c0, o1b = x1b * c1 - x2b * s1, o2b = x1b * s1 + x2b * c1;
                x1a = o1a; x2a = o2a; x1b = o1b; x2b = o2b;
            }
            *(unsigned*)(hp[k] + 2 * li) = pk2(x1a * scale, x1b * scale);
            *(unsigned*)(hp[k] + DIM / 2 + 2 * li) = pk2(x2a * scale, x2b * scale);
        }
    }
}

template <int HD, int MODE>
__device__ __forceinline__ void attn_unit(LAS unsigned char* lds, const bf16_t* Qp, int qpitch, const bf16_t* Kp, int kpitch, const bf16_t* Vtp,
                                          const bf16_t* Gp, int gpitch, bf16_t* Yp, const float* Cfp, const u64* Mp, float sink2, float b2x2, int qb,
                                          int chunk = -1, float* part = nullptr, unsigned* pcnt = nullptr, volatile LAS int* bc = nullptr, const float* Ncp = nullptr) {
    constexpr int KROW = HD * 2 + 16, VROW = 136, KT_BYTES = 64 * KROW, VT_BYTES = HD * VROW, BUF = KT_BYTES + VT_BYTES;
    constexpr int KPT = (64 * HD / 8) / 512, VPT = (HD * 8) / 512, NSTEP = HD / 16, NDB = HD / 32, CPR = HD / 8;
    const int tid = tid_fresh(), lane = tid & 63, w = __builtin_amdgcn_readfirstlane(tid >> 6), l31 = lane & 31, hh = lane >> 5;
    const int q0w = qb * 256 + w * 32, qg = q0w + l31;
    int t_hi = 4 * qb + 3; int t_lo = 0;
    if (MODE == 2) { t_lo = 4 * qb - 2; if (t_lo < 0) t_lo = 0; }
    if (MODE == 1) { if (chunk == 0) t_hi = 15; else if (chunk == 1) t_lo = 16; }
    bf16x8 qf[NSTEP];
#pragma unroll
    for (int s = 0; s < NSTEP; ++s) qf[s] = *(const bf16x8*)(Qp + (size_t)qg * qpitch + 16 * s + 8 * hh);
    f32x16 o[NDB];
#pragma unroll
    for (int d = 0; d < NDB; ++d)
#pragma unroll
        for (int r = 0; r < 16; ++r) o[d][r] = 0.f;
    float m = -INFINITY, l = 0.f;
    if (MODE == 2) { m = sink2; l = (hh == 0) ? 1.f : 0.f; }
    if (MODE == 1) m = 0.f;
    u32x4 kreg[KPT], vreg[VPT];
#define AT_GLOAD(t) do { _Pragma("unroll") for (int i_ = 0; i_ < KPT; ++i_) { const int c_ = tid + 512 * i_; const int row_ = c_ / CPR, ch_ = c_ % CPR; \
            kreg[i_] = *(const u32x4*)(Kp + (size_t)((t) * 64 + row_) * kpitch + ch_ * 8); } \
        _Pragma("unroll") for (int i_ = 0; i_ < VPT; ++i_) { const int c_ = tid + 512 * i_; const int d_ = c_ >> 3, ch_ = c_ & 7; \
            vreg[i_] = *(const u32x4*)(Vtp + (size_t)d_ * VTP + (t) * 64 + ch_ * 8); } } while (0)
#define AT_LWRITE(buf) do { LAS unsigned char* kb_ = lds + (buf) * BUF; \
        _Pragma("unroll") for (int i_ = 0; i_ < KPT; ++i_) { const int c_ = tid + 512 * i_; const int row_ = c_ / CPR, ch_ = c_ % CPR; *(LAS u32x4*)(kb_ + row_ * KROW + ch_ * 16) = kreg[i_]; } \
        _Pragma("unroll") for (int i_ = 0; i_ < VPT; ++i_) { const int c_ = tid + 512 * i_; const int d_ = c_ >> 3, ch_ = c_ & 7; LAS unsigned char* vp_ = kb_ + KT_BYTES + d_ * VROW + ch_ * 16; \
            *(LAS u32x2*)(vp_) = (u32x2){vreg[i_].x, vreg[i_].y}; *(LAS u32x2*)(vp_ + 8) = (u32x2){vreg[i_].z, vreg[i_].w}; } } while (0)
    const int t_first = (MODE == 0) ? t_hi : t_lo, t_last = (MODE == 0) ? t_lo : t_hi, dt = (MODE == 0) ? -1 : 1;
    float cq0u = 0.f, cq0w = 0.f;
    if (MODE == 0) { cq0u = Cfp[qb * 256]; cq0w = Cfp[q0w]; }
    AT_GLOAD(t_first); AT_LWRITE(0);
    __syncthreads();
    for (int t = t_first, it_ = 0; ; t += dt, ++it_) {
        const int buf = it_ & 1;
        bool more = (t != t_last);
        if (MODE == 0 && more) { const int tn = t - 1; if (64 * tn + 63 < qb * 256) { if (b2x2 + cq0u - Cfp[64 * tn + 63] < -150.f) more = false; } }
        if (more) AT_GLOAD(t + dt);
        bool active = (64 * t <= q0w + 31);
        if (MODE == 2) active = active && (64 * t + 63 > q0w - 128);
        if (MODE == 0) { if (64 * t + 63 < q0w) { if (b2x2 + cq0w - Cfp[64 * t + 63] < -150.f) active = false; } }
        if (active) {
            const LAS unsigned char* kb = lds + buf * BUF; const LAS unsigned char* vb = kb + KT_BYTES;
            f32x16 st[2];
            {
                bf16x8 ka[NSTEP], kc[NSTEP];
#pragma unroll
                for (int s = 0; s < NSTEP; ++s) ka[s] = *(const LAS bf16x8*)(kb + l31 * KROW + s * 32 + hh * 16);
                __builtin_amdgcn_sched_barrier(0);
                if (MODE == 0) {
#pragma unroll
                    for (int blk = 0; blk < 2; ++blk)
#pragma unroll
                        for (int g4 = 0; g4 < 4; ++g4) { const f32x4 nck = *(const f32x4*)(Ncp + t * 64 + 32 * blk + 8 * g4 + 4 * hh);
#pragma unroll
                            for (int e = 0; e < 4; ++e) st[blk][4 * g4 + e] = nck[e]; }
                } else {
                    const float c0_ = (MODE == 1) ? -b2x2 : 0.f;
#pragma unroll
                    for (int r = 0; r < 16; ++r) { st[0][r] = c0_; st[1][r] = c0_; }
                }
#pragma unroll
                for (int s = 0; s < NSTEP; ++s) { kc[s] = *(const LAS bf16x8*)(kb + (32 + l31) * KROW + s * 32 + hh * 16);
                    st[0] = __builtin_amdgcn_mfma_f32_32x32x16_bf16(ka[s], qf[s], st[0], 0, 0, 0); }
                __builtin_amdgcn_sched_barrier(0);
#pragma unroll
                for (int s = 0; s < NSTEP; ++s) st[1] = __builtin_amdgcn_mfma_f32_32x32x16_bf16(kc[s], qf[s], st[1], 0, 0, 0);
            }
            unsigned wlo = 0u, whi = 0u;
            if (MODE == 1) { const u64 mw = Mp[(size_t)qg * 32 + t] >> (4 * hh); wlo = (unsigned)mw; whi = (unsigned)(mw >> 32); }
            if (MODE != 1) {
                bool need = (64 * t + 63 > q0w);
                if (MODE == 2) need = need || (64 * t <= q0w + 31 - 128);
                if (need) {
#pragma unroll
                    for (int blk = 0; blk < 2; ++blk)
#pragma unroll
                        for (int r = 0; r < 16; ++r) { const int key = 64 * t + 32 * blk + 8 * (r >> 2) + 4 * hh + (r & 3);
                            bool bad = key > qg; if (MODE == 2) bad = bad || (key <= qg - 128);
                            if (bad) st[blk][r] = -INFINITY; }
                }
            }
            float ps = 0.f;
            if (MODE == 1) {
#pragma unroll
                for (int blk = 0; blk < 2; ++blk) { const unsigned wd = blk ? whi : wlo;
#pragma unroll
                    for (int r = 0; r < 16; ++r) { const int bit = 8 * (r >> 2) + (r & 3); int sel; asm("v_bfe_i32 %0, %1, %2, 1" : "=v"(sel) : "v"(wd), "n"(bit));
                        const float p = __int_as_float(__float_as_int(__builtin_amdgcn_exp2f(st[blk][r])) & sel); st[blk][r] = p; ps += p; } }
                l += ps;
            } else {
                float mt = st[0][0];
#pragma unroll
                for (int r = 1; r < 16; ++r) mt = fmaxf(mt, st[0][r]);
#pragma unroll
                for (int r = 0; r < 16; ++r) mt = fmaxf(mt, st[1][r]);
                mt = fmaxf(mt, __shfl_xor(mt, 32));
                const float mn = fmaxf(m, mt);
                const float ms = (mn == -INFINITY) ? 0.f : mn;
                const float alpha = __builtin_amdgcn_exp2f(m - ms);
                m = mn;
                st[0] = st[0] - ms; st[1] = st[1] - ms;
#pragma unroll
                for (int blk = 0; blk < 2; ++blk)
#pragma unroll
                    for (int r = 0; r < 16; ++r) { const float p = __builtin_amdgcn_exp2f(st[blk][r]); st[blk][r] = p; ps += p; }
                l = l * alpha + ps;
                if (!__all(alpha == 1.0f)) {
#pragma unroll
                    for (int d = 0; d < NDB; ++d)
#pragma unroll
                        for (int r = 0; r < 16; ++r) o[d][r] *= alpha;
                }
            }
            bf16x8 pf[2][2];
#pragma unroll
            for (int blk = 0; blk < 2; ++blk)
#pragma unroll
                for (int s = 0; s < 2; ++s) { u32x4 pw; pw.x = pg8::cvt_pk_bf16(st[blk][8 * s + 0], st[blk][8 * s + 1]); pw.y = pg8::cvt_pk_bf16(st[blk][8 * s + 2], st[blk][8 * s + 3]);
                    pw.z = pg8::cvt_pk_bf16(st[blk][8 * s + 4], st[blk][8 * s + 5]); pw.w = pg8::cvt_pk_bf16(st[blk][8 * s + 6], st[blk][8 * s + 7]); pf[blk][s] = __builtin_bit_cast(bf16x8, pw); }
            {
#pragma unroll
                for (int dp = 0; dp < NDB; dp += 2) {
                    u32x4 vf[2][2][2];
#pragma unroll
                    for (int d2 = 0; d2 < 2; ++d2)
#pragma unroll
                        for (int blk = 0; blk < 2; ++blk)
#pragma unroll
                            for (int s = 0; s < 2; ++s) { const LAS unsigned char* vp = vb + (32 * (dp + d2) + l31) * VROW + (32 * blk + 16 * s + 4 * hh) * 2;
                                const u32x2 v0 = *(const LAS u32x2*)(vp), v1 = *(const LAS u32x2*)(vp + 16); vf[d2][blk][s] = (u32x4){v0.x, v0.y, v1.x, v1.y}; }
                    __builtin_amdgcn_sched_barrier(0);
                    __builtin_amdgcn_s_setprio(1);
#pragma unroll
                    for (int d2 = 0; d2 < 2; ++d2)
#pragma unroll
                        for (int blk = 0; blk < 2; ++blk)
#pragma unroll
                            for (int s = 0; s < 2; ++s) o[dp + d2] = __builtin_amdgcn_mfma_f32_32x32x16_bf16(__builtin_bit_cast(bf16x8, vf[d2][blk][s]), pf[blk][s], o[dp + d2], 0, 0, 0);
                    __builtin_amdgcn_s_setprio(0);
                    __builtin_amdgcn_sched_barrier(0);
                }
            }
        }
        if (more) AT_LWRITE(buf ^ 1);
        __syncthreads();
        if (!more) break;
    }
#undef AT_GLOAD
#undef AT_LWRITE
    if (MODE == 1 && chunk >= 0) {
        float* mine = part + (size_t)chunk * (8 * (NDB * 16 + 2) * 64); float* other = part + (size_t)(chunk ^ 1) * (8 * (NDB * 16 + 2) * 64);
        gu64* pw = (gu64*)(mine + (size_t)w * (NDB * 16 + 2) * 64) + lane;
#pragma unroll
        for (int d = 0; d < NDB; ++d)
#pragma unroll
            for (int r = 0; r < 16; r += 2) __hip_atomic_store(pw + (d * 8 + (r >> 1)) * 64, (u64)__float_as_uint(o[d][r]) | ((u64)__float_as_uint(o[d][r + 1]) << 32), __ATOMIC_RELAXED, __HIP_MEMORY_SCOPE_AGENT);
        __hip_atomic_store(pw + (NDB * 8) * 64, (u64)__float_as_uint(m) | ((u64)__float_as_uint(l) << 32), __ATOMIC_RELAXED, __HIP_MEMORY_SCOPE_AGENT);
        asm volatile("s_waitcnt vmcnt(0)" ::: "memory");
        __syncthreads();
        if (tid == 0) {
            const unsigned old_ = __hip_atomic_fetch_add(pcnt, 1u, __ATOMIC_RELAXED, __HIP_MEMORY_SCOPE_AGENT);
            if (old_ != 0u) { __builtin_amdgcn_fence(__ATOMIC_ACQUIRE, "agent"); asm volatile("s_waitcnt vmcnt(0)" ::: "memory"); }
            bc[1] = (int)old_;
        }
        __syncthreads();
        const int arrived = bc[1];
        if (arrived == 0) return;
        const u64* po = (const u64*)(other + (size_t)w * (NDB * 16 + 2) * 64) + lane;
        const u64 ml2 = po[(NDB * 8) * 64];
        const float m2 = __uint_as_float((unsigned)ml2), l2 = __uint_as_float((unsigned)(ml2 >> 32));
        const float mt = fmaxf(m, m2), ms = (mt == -INFINITY) ? 0.f : mt;
        const float fa = __builtin_amdgcn_exp2f(m - ms), fb = __builtin_amdgcn_exp2f(m2 - ms);
        l = l * fa + l2 * fb;
#pragma unroll
        for (int d = 0; d < NDB; ++d)
#pragma unroll
            for (int r = 0; r < 16; r += 2) { const u64 v2 = po[(d * 8 + (r >> 1)) * 64];
                o[d][r] = o[d][r] * fa + __uint_as_float((unsigned)v2) * fb; o[d][r + 1] = o[d][r + 1] * fa + __uint_as_float((unsigned)(v2 >> 32)) * fb; }
    }
    l += __shfl_xor(l, 32);
    const float inv = 1.f / l;
#pragma unroll
    for (int db = 0; db < NDB; ++db)
#pragma unroll
        for (int g4 = 0; g4 < 4; ++g4) { const int d0 = 32 * db + 8 * g4 + 4 * hh;
            const u32x2 gw = *(const u32x2*)(Gp + (size_t)qg * gpitch + d0);
            const float g0 = bf2f((unsigned short)(gw.x & 0xffffu)), g1 = bf2f((unsigned short)(gw.x >> 16)), g2 = bf2f((unsigned short)(gw.y & 0xffffu)), g3 = bf2f((unsigned short)(gw.y >> 16));
            const float y0 = o[db][4 * g4 + 0] * inv * (g0 / (1.f + __expf(-g0))), y1 = o[db][4 * g4 + 1] * inv * (g1 / (1.f + __expf(-g1)));
            const float y2 = o[db][4 * g4 + 2] * inv * (g2 / (1.f + __expf(-g2))), y3 = o[db][4 * g4 + 3] * inv * (g3 / (1.f + __expf(-g3)));
            u32x2 yw; yw.x = pk2(y0, y1); yw.y = pk2(y2, y3);
            *(u32x2*)(Yp + (size_t)qg * DM + d0) = yw; }
}


__device__ __forceinline__ void swa_unit(LAS unsigned char* lds, const bf16_t* hb, const bf16_t* Vtp, bf16_t* Yb, const float* sinks, const float* gsw, int kvh, int j) {
    constexpr int KROW = 144, VROW = 136, KT = 64 * KROW, VTB = 64 * VROW, V_OFF = 4 * KT;
    const int tid = tid_fresh(), lane = tid & 63, w = __builtin_amdgcn_readfirstlane(tid >> 6), l31 = lane & 31, hh = lane >> 5;
    const int rg = w & 3, hg = w >> 2, t0 = 2 * j - 2;
    {
        u32x4 kr[4], vr[4];
#pragma unroll
        for (int i = 0; i < 4; ++i) { const int cc = tid, row = cc >> 3, ch = cc & 7, t = t0 + i;
            kr[i] = (u32x4){0u, 0u, 0u, 0u}; vr[i] = kr[i];
            if (t >= 0) { kr[i] = *(const u32x4*)(hb + C1_K + kvh * 64 + (size_t)(t * 64 + row) * N1 + ch * 8); vr[i] = *(const u32x4*)(Vtp + (size_t)row * VTP + t * 64 + ch * 8); } }
#pragma unroll
        for (int i = 0; i < 4; ++i) { const int cc = tid, row = cc >> 3, ch = cc & 7;
            *(LAS u32x4*)(lds + i * KT + row * KROW + ch * 16) = kr[i];
            LAS unsigned char* vp = lds + V_OFF + i * VTB + row * VROW + ch * 16;
            *(LAS u32x2*)(vp) = (u32x2){vr[i].x, vr[i].y}; *(LAS u32x2*)(vp + 8) = (u32x2){vr[i].z, vr[i].w}; }
    }
    __syncthreads();
    const int q0w = 128 * j + 32 * rg, qg = q0w + l31;
    float mref;
    { float gq = fabsf(gsw[lane]), gk = fabsf(gsw[64 + lane]);
#pragma unroll
      for (int o_ = 1; o_ < 64; o_ <<= 1) { gq = fmaxf(gq, __shfl_xor(gq, o_)); gk = fmaxf(gk, __shfl_xor(gk, o_)); }
      mref = fminf(11.6f * gq * gk, 60.f); }
    bf16x8 qn[4];
#pragma unroll
    for (int s = 0; s < 4; ++s) qn[s] = *(const bf16x8*)(hb + C1_Q + (kvh * 8 + hg * 4) * 64 + (size_t)qg * N1 + 16 * s + 8 * hh);
    for (int hi = 0; hi < 4; ++hi) {
        const int hq = kvh * 8 + hg * 4 + hi;
        bf16x8 qf[4];
#pragma unroll
        for (int s = 0; s < 4; ++s) qf[s] = qn[s];
        if (hi < 3) {
#pragma unroll
            for (int s = 0; s < 4; ++s) qn[s] = *(const bf16x8*)(hb + C1_Q + (hq + 1) * 64 + (size_t)qg * N1 + 16 * s + 8 * hh);
        }
        u32x2 gq[8];
#pragma unroll
        for (int i = 0; i < 8; ++i) gq[i] = *(const u32x2*)(hb + C1_G + hq * 64 + (size_t)qg * N1 + 32 * (i >> 2) + 8 * (i & 3) + 4 * hh);
        f32x16 o[2];
#pragma unroll
        for (int d = 0; d < 2; ++d)
#pragma unroll
            for (int r = 0; r < 16; ++r) o[d][r] = 0.f;
        float l = (hh == 0) ? __builtin_amdgcn_exp2f(sinks[hq] * LOG2E - mref) : 0.f;
        for (int sl = 0; sl < 4; ++sl) {
            const int t = t0 + sl;
            if (t < 0) continue;
            if (!((64 * t <= q0w + 31) && (64 * t + 63 > q0w - 128))) continue;
            const LAS unsigned char* kb = lds + sl * KT; const LAS unsigned char* vb = lds + V_OFF + sl * VTB;
            f32x16 st[2];
            {
                bf16x8 ka[4], kc[4];
#pragma unroll
                for (int s = 0; s < 4; ++s) ka[s] = *(const LAS bf16x8*)(kb + l31 * KROW + s * 32 + hh * 16);
#pragma unroll
                for (int s = 0; s < 4; ++s) kc[s] = *(const LAS bf16x8*)(kb + (32 + l31) * KROW + s * 32 + hh * 16);
#pragma unroll
                for (int r = 0; r < 16; ++r) { st[0][r] = -mref; st[1][r] = -mref; }
#pragma unroll
                for (int s = 0; s < 4; ++s) st[0] = __builtin_amdgcn_mfma_f32_32x32x16_bf16(ka[s], qf[s], st[0], 0, 0, 0);
#pragma unroll
                for (int s = 0; s < 4; ++s) st[1] = __builtin_amdgcn_mfma_f32_32x32x16_bf16(kc[s], qf[s], st[1], 0, 0, 0);
            }
            if ((64 * t + 63 > q0w) || (64 * t <= q0w + 31 - 128)) {
#pragma unroll
                for (int blk = 0; blk < 2; ++blk)
#pragma unroll
                    for (int r = 0; r < 16; ++r) { const int key = 64 * t + 32 * blk + 8 * (r >> 2) + 4 * hh + (r & 3);
                        if (key > qg || key <= qg - 128) st[blk][r] = -INFINITY; }
            }
            float ps = 0.f;
#pragma unroll
            for (int blk = 0; blk < 2; ++blk)
#pragma unroll
                for (int r = 0; r < 16; ++r) { const float p = __builtin_amdgcn_exp2f(st[blk][r]); st[blk][r] = p; ps += p; }
            l += ps;
            bf16x8 pf[2][2];
#pragma unroll
            for (int blk = 0; blk < 2; ++blk)
#pragma unroll
                for (int s = 0; s < 2; ++s) { u32x4 pw; pw.x = pg8::cvt_pk_bf16(st[blk][8 * s + 0], st[blk][8 * s + 1]); pw.y = pg8::cvt_pk_bf16(st[blk][8 * s + 2], st[blk][8 * s + 3]);
                    pw.z = pg8::cvt_pk_bf16(st[blk][8 * s + 4], st[blk][8 * s + 5]); pw.w = pg8::cvt_pk_bf16(st[blk][8 * s + 6], st[blk][8 * s + 7]); pf[blk][s] = __builtin_bit_cast(bf16x8, pw); }
            {
                u32x4 vf[2][2][2];
#pragma unroll
                for (int d2 = 0; d2 < 2; ++d2)
#pragma unroll
                    for (int blk = 0; blk < 2; ++blk)
#pragma unroll
                        for (int s = 0; s < 2; ++s) { const LAS unsigned char* vp = vb + (32 * d2 + l31) * VROW + (32 * blk + 16 * s + 4 * hh) * 2;
                            const u32x2 v0 = *(const LAS u32x2*)(vp), v1 = *(const LAS u32x2*)(vp + 16); vf[d2][blk][s] = (u32x4){v0.x, v0.y, v1.x, v1.y}; }
#pragma unroll
                for (int d2 = 0; d2 < 2; ++d2)
#pragma unroll
                    for (int blk = 0; blk < 2; ++blk)
#pragma unroll
                        for (int s = 0; s < 2; ++s) o[d2] = __builtin_amdgcn_mfma_f32_32x32x16_bf16(__builtin_bit_cast(bf16x8, vf[d2][blk][s]), pf[blk][s], o[d2], 0, 0, 0);
            }
        }
        l += __shfl_xor(l, 32);
        const float inv = 1.f / l;
#pragma unroll
        for (int db = 0; db < 2; ++db)
#pragma unroll
            for (int g4 = 0; g4 < 4; ++g4) { const int d0 = 32 * db + 8 * g4 + 4 * hh;
                const u32x2 gw = gq[db * 4 + g4];
                const float g0 = bf2f((unsigned short)(gw.x & 0xffffu)), g1 = bf2f((unsigned short)(gw.x >> 16)), g2 = bf2f((unsigned short)(gw.y & 0xffffu)), g3 = bf2f((unsigned short)(gw.y >> 16));
                const float y0 = o[db][4 * g4 + 0] * inv * (g0 / (1.f + __expf(-g0))), y1 = o[db][4 * g4 + 1] * inv * (g1 / (1.f + __expf(-g1)));
                const float y2 = o[db][4 * g4 + 2] * inv * (g2 / (1.f + __expf(-g2))), y3 = o[db][4 * g4 + 3] * inv * (g3 / (1.f + __expf(-g3)));
                u32x2 yw; yw.x = pk2(y0, y1); yw.y = pk2(y2, y3);
                *(u32x2*)(Yb + (size_t)qg * DM + hq * 64 + d0) = yw; }
    }
    __syncthreads();
}

__device__ __forceinline__ void idx_unit(LAS unsigned char* lds, const bf16_t* H, const float* SIDE, u64* MASK, int b, int u) {
    const int tid = tid_fresh(), lane = tid & 63, w = __builtin_amdgcn_readfirstlane(tid >> 6), l31 = lane & 31, hh = lane >> 5;
    LAS unsigned* sc = (LAS unsigned*)lds;
    const int q0 = 16 * u + 2 * w;
    const int qi = l31 >> 4, head = l31 & 15;
    const bf16_t* iqp = H + (size_t)(b * SEQ + q0 + qi) * N0 + C_IQ + head * 64 + 8 * hh;
    bf16x8 aq[4];
#pragma unroll
    for (int s = 0; s < 4; ++s) aq[s] = *(const bf16x8*)(iqp + 16 * s);
    float w0[8], w1[8];
#pragma unroll
    for (int r = 0; r < 8; ++r) { const int hd = (r & 3) + 8 * (r >> 2) + 4 * hh;
        w0[r] = SIDE[(size_t)(b * SEQ + q0) * 256 + 72 + hd] * 0.03125f; w1[r] = SIDE[(size_t)(b * SEQ + q0 + 1) * 256 + 72 + hd] * 0.03125f; }
    const int ngrp = (16 * u + 15) / 128 + 1;
    LAS unsigned char* ikb = lds + LDS_IK_OFF;
    const bf16_t* ikg = H + (size_t)(b * SEQ) * N0 + C_IK;
    u32x4 pre[2];
#pragma unroll
    for (int i = 0; i < 2; ++i) { const int c = tid + 512 * i; pre[i] = *(const u32x4*)(ikg + (size_t)(c >> 3) * N0 + (c & 7) * 8); }
    for (int prs_ = 0; prs_ < ((PROBE_IDX == 1) ? 3 : 1); ++prs_)
    for (int g = 0; g < ngrp; ++g) {
        if (prs_ > 0 && g == 0) {
#pragma unroll
            for (int i = 0; i < 2; ++i) { const int c = tid + 512 * i; pre[i] = *(const u32x4*)(ikg + (size_t)(c >> 3) * N0 + (c & 7) * 8); } }
        __syncthreads();
#pragma unroll
        for (int i = 0; i < 2; ++i) { const int c = tid + 512 * i; *(LAS u32x4*)(ikb + (c >> 3) * 144 + (c & 7) * 16) = pre[i]; }
        __syncthreads();
        if (g + 1 < ngrp) {
#pragma unroll
            for (int i = 0; i < 2; ++i) { const int c = tid + 512 * i; pre[i] = *(const u32x4*)(ikg + (size_t)(128 * (g + 1) + (c >> 3)) * N0 + (c & 7) * 8); }
        }
#pragma unroll
        for (int kb = 0; kb < 4; ++kb) {
            f32x16 c;
#pragma unroll
            for (int r = 0; r < 16; ++r) c[r] = 0.f;
#pragma unroll
            for (int s = 0; s < 4; ++s) { const bf16x8 bk = *(const LAS bf16x8*)(ikb + (32 * kb + l31) * 144 + 32 * s + 16 * hh);
                c = __builtin_amdgcn_mfma_f32_32x32x16_bf16(aq[s], bk, c, 0, 0, 0); }
            float s0 = 0.f, s1 = 0.f;
#pragma unroll
            for (int r = 0; r < 8; ++r) { s0 += w0[r] * fmaxf(c[r], 0.f); s1 += w1[r] * fmaxf(c[8 + r], 0.f); }
            s0 += __shfl_xor(s0, 32); s1 += __shfl_xor(s1, 32);
            const float val = (hh ? s1 : s0) + 0.0f;
            const int key = 128 * g + 32 * kb + l31, qq = q0 + hh;
            unsigned uv = __float_as_uint(val); uv ^= (uv >> 31) ? 0xffffffffu : 0x80000000u;
            sc[(2 * w + hh) * 2048 + key] = (key <= qq) ? uv : 0u;
        }
    }
    LDS_WAIT(); asm volatile("" ::: "memory");
    const u64 lt = (1ull << lane) - 1ull;
    for (int prq_ = 0; prq_ < ((PROBE_IDX == 2) ? 3 : 1); ++prq_)
    for (int rr = 0; rr < 2; ++rr) {
        const int row = 2 * w + rr, qq = 16 * u + row;
        unsigned kv[32];
#pragma unroll
        for (int i = 0; i < 32; ++i) { const int idx = 64 * i + lane; kv[i] = (idx <= qq) ? sc[row * 2048 + idx] : 0u; }
        unsigned T = 0u;
        const int nblk8 = (qq >> 9) + 1;
        if (qq + 1 > 256) {
            for (int bit = 31; bit >= 0; --bit) {
                const unsigned cand = T | (1u << bit); int c = 0;
#pragma unroll
                for (int blk = 0; blk < 4; ++blk) if (blk < nblk8) {
#pragma unroll
                    for (int j = 0; j < 8; ++j) c += (kv[8 * blk + j] >= cand) ? 1 : 0;
                }
                u64 bm[6];
#pragma unroll
                for (int bb = 0; bb < 6; ++bb) bm[bb] = __ballot((c >> bb) & 1);
                int cnt = 0;
#pragma unroll
                for (int bb = 0; bb < 6; ++bb) cnt += __popcll(bm[bb]) << bb;
                if (cnt >= 256) T = cand;
                if (cnt == 256) break;
            }
        }
        int cgt = 0;
#pragma unroll
        for (int blk = 0; blk < 4; ++blk) {
            u64 mm[8];
#pragma unroll
            for (int j = 0; j < 8; ++j) mm[j] = __ballot(kv[8 * blk + j] > T);
#pragma unroll
            for (int j = 0; j < 8; ++j) cgt += __popcll(mm[j]);
        }
        const int need = (T == 0u) ? 0 : 256 - cgt;
        int running = 0; u64 myword = 0ull;
#pragma unroll
        for (int i = 0; i < 32; ++i) { const bool eq = (kv[i] == T); const u64 em = __ballot(eq); const int rank = running + __popcll(em & lt);
            const bool sel = (kv[i] > T) || (eq && rank < need); const u64 word = __ballot(sel); if (lane == i) myword = word; running += __popcll(em); }
        if (lane < 32) __hip_atomic_store((gu64*)(MASK + ((size_t)b * SEQ + qq) * 32 + lane), myword, __ATOMIC_RELAXED, __HIP_MEMORY_SCOPE_AGENT);
    }
}

#define XB_TMO      128
#define XB_XCNT(j)  (256  + 64 * (j))
#define XB_XSUB(j)  (1280 + 64 * (j))
#define XB_XGEN(j)  (2304 + 64 * (j))
#define XB_TOP      3328
#define XB_TOPGEN   3392
#define XCD_BAR_WORDS 3456
#define XB_SPIN_CAP (1u << 18)

__device__ __forceinline__ unsigned xb_ld(unsigned* p)              { return __hip_atomic_load(p, __ATOMIC_RELAXED, __HIP_MEMORY_SCOPE_AGENT); }
__device__ __forceinline__ unsigned xb_add(unsigned* p, unsigned v) { return __hip_atomic_fetch_add(p, v, __ATOMIC_RELAXED, __HIP_MEMORY_SCOPE_AGENT); }
__device__ __forceinline__ unsigned xb_xcc_id() { return (unsigned)__builtin_amdgcn_s_getreg((3 << 11) | 20) & 0xFu; }
#define XB_SPIN(cond, bar) do { unsigned _sp = 0; while (cond) { __builtin_amdgcn_s_sleep(1); \
    if ((++_sp & 255u) == 0u) { if (xb_ld(&(bar)[XB_TMO])) break; if (_sp > XB_SPIN_CAP) { atomicAdd(&(bar)[XB_TMO], 1u); break; } } } } while (0)

struct XcdBarrier {
    unsigned* bar; unsigned x;
    volatile LAS unsigned* st;
};

__device__ __forceinline__ XcdBarrier xcd_barrier_post(unsigned* bar, volatile LAS unsigned* st) {
    XcdBarrier b; b.bar = bar; b.x = xb_xcc_id(); b.st = st;
    if (threadIdx.x == 0) (void)xb_add(&bar[XB_XCNT(b.x)], 1u);
    return b;
}
__device__ __forceinline__ void xcd_barrier_complete(unsigned* bar, unsigned x, unsigned& nloc, unsigned& nx) {
    const unsigned G = gridDim.x * gridDim.y * gridDim.z;
    unsigned sum, cnt, mine, sp = 0u;
    for (;;) {
        sum = 0u; cnt = 0u; mine = 0u;
#pragma unroll
        for (unsigned j = 0; j < 16; ++j) { const unsigned c = xb_ld(&bar[XB_XCNT(j)]); sum += c; cnt += (c > 0u) ? 1u : 0u; mine = (j == x) ? c : mine; }
        if (sum == G) break;
        __builtin_amdgcn_s_sleep(1);
        if ((++sp & 255u) == 0u) { if (xb_ld(&bar[XB_TMO])) break; if (sp > XB_SPIN_CAP) { atomicAdd(&bar[XB_TMO], 1u); break; } }
    }
    nloc = mine > 0u ? mine : 1u; nx = cnt > 0u ? cnt : 1u;
}

__device__ __forceinline__ void xcd_barrier(const XcdBarrier& b) {
    asm volatile("s_waitcnt vmcnt(0)" ::: "memory");
    __syncthreads();
    if (threadIdx.x == 0) {
        unsigned* bar = b.bar;
        __builtin_amdgcn_s_waitcnt(0);
        unsigned nloc = b.st[0], nx = b.st[1];
        if (nloc == 0u) { xcd_barrier_complete(bar, b.x, nloc, nx); b.st[0] = nloc; b.st[1] = nx; }
        const unsigned old = xb_add(&bar[XB_XSUB(b.x)], 1u);
        const unsigned gen = old / nloc;
        if (old + 1u == (gen + 1u) * nloc) {
            __builtin_amdgcn_fence(__ATOMIC_RELEASE, "agent");
            asm volatile("s_waitcnt vmcnt(0)" ::: "memory");
            const unsigned og = xb_add(&bar[XB_TOP], 1u);
            const unsigned tg = og / nx;
            if (og + 1u == (tg + 1u) * nx) xb_add(&bar[XB_TOPGEN], 1u);
            else XB_SPIN(xb_ld(&bar[XB_TOPGEN]) == tg, bar);
            __builtin_amdgcn_fence(__ATOMIC_ACQUIRE, "agent");
            xb_add(&bar[XB_XGEN(b.x)], 1u);
            asm volatile("s_waitcnt vmcnt(0)" ::: "memory");
        } else {
            XB_SPIN(xb_ld(&bar[XB_XGEN(b.x)]) == gen, bar);
            __builtin_amdgcn_fence(__ATOMIC_ACQUIRE, "agent");
            asm volatile("s_waitcnt vmcnt(0)" ::: "memory");
        }
    }
    __syncthreads();
}

struct Params { const float* in[13]; float* out; unsigned char* ws; };


typedef const __attribute__((address_space(4))) Params* KParams;
__device__ __forceinline__ KParams kparams() { KParams p = (KParams)__builtin_amdgcn_kernarg_segment_ptr(); asm volatile("" : "+s"(p)); return p; }
#define PHASE_PTRS() KParams pp_ = kparams(); \
    const int tid = tid_fresh(), lane = tid & 63, wave = __builtin_amdgcn_readfirstlane(tid >> 6); const int G = gridDim.x, bx = blockIdx.x; const int gw = bx * 8 + wave, NGW = G * 8; \
    (void)lane; (void)gw; (void)NGW; \
    const float* x = pp_->in[0]; const float* norm_even = pp_->in[1]; const float* w_in_even = pp_->in[2]; const float* b_f = pp_->in[3]; \
    const float* g_fox = pp_->in[4]; const float* g_dsa = pp_->in[5]; const float* g_kidx = pp_->in[6]; const float* w_out_even = pp_->in[7]; \
    const float* norm_odd = pp_->in[8]; const float* w_in_odd = pp_->in[9]; const float* g_swa = pp_->in[10]; const float* sinks = pp_->in[11]; const float* w_out_odd = pp_->in[12]; \
    unsigned char* ws = pp_->ws; float* out = pp_->out; \
    unsigned* ctl = (unsigned*)(ws + WS_CTL); \
    bf16_t* WT0 = (bf16_t*)(ws + WS_WT0); bf16_t* WO0 = (bf16_t*)(ws + WS_WO0); bf16_t* WT1 = (bf16_t*)(ws + WS_WT1); bf16_t* WO1 = (bf16_t*)(ws + WS_WO1); \
    bf16_t* ACT = (bf16_t*)(ws + WS_ACT); bf16_t* H = (bf16_t*)(ws + WS_H); bf16_t* VT = (bf16_t*)(ws + WS_VT); \
    float* ROPE = (float*)(ws + WS_ROPE); float* SS = (float*)(ws + WS_SS); bf16_t* XG = VT; bf16_t* VT1 = H + (size_t)NTOK * N1; (void)SS; (void)XG; (void)VT1; \
    float* SIDE = (float*)((unsigned char*)out + DO_SIDE); float* CF = (float*)((unsigned char*)out + DO_CF); u64* MASK = (u64*)((unsigned char*)out + DO_MASK); \
    (void)x; (void)norm_even; (void)w_in_even; (void)b_f; (void)g_fox; (void)g_dsa; (void)g_kidx; (void)w_out_even; (void)norm_odd; (void)w_in_odd; (void)g_swa; (void)sinks; (void)w_out_odd; \
    (void)ctl; (void)WT0; (void)WO0; (void)WT1; (void)WO1; (void)ACT; (void)H; (void)VT; (void)ROPE; (void)SIDE; (void)CF; (void)MASK;

__global__ void __launch_bounds__(512, 2) fwd_megakernel(Params P) {
    extern __shared__ __attribute__((aligned(16))) unsigned char lds_raw[];
    LAS unsigned char* lds = (LAS unsigned char*)lds_raw;
    volatile LAS int* lctl = (volatile LAS int*)(lds + LDS_CTL_OFF);
    cg::grid_group grid = cg::this_grid();
    if (threadIdx.x < 64) lctl[threadIdx.x] = 0;
    __syncthreads();
    XcdBarrier xbar;
    { KParams pq_ = kparams(); xbar = xcd_barrier_post((unsigned*)(pq_->ws + WS_BAR), (volatile LAS unsigned*)(lctl + 8)); }
    if (gridDim.x == 0x7fffffffu) grid.sync();
#define GRID_SYNC() xcd_barrier(xbar)
    for (int rep_ = 0; rep_ < REP(0); ++rep_) {
    {
        PHASE_PTRS();
        LAS float* scr = (LAS float*)(lds + wave * 8448);
        constexpr int I0 = 32 * (N0T / 32);
        for (int it = gw; it < I0; it += NGW) p0_transpose_item(w_in_even, EVEN_IN, 0, WT0, scr, it, N0T / 32, lane);
        for (int mrow = gw; mrow < NTOK; mrow += NGW) rms_row_to_bf16(x + (size_t)mrow * DM, norm_even, ACT + (size_t)mrow * DM, lane);
        if (bx == 0 && tid < 96) {
            const int j = tid;
            const double ex = (j < 64) ? (double)(2 * j) / 128.0 : (double)(2 * (j - 64)) / 64.0;
            ROPE[j] = (float)(exp2(-ex * 13.287712379549449) * 0.15915494309189535);
        }
    }
    GRID_SYNC();
    }
    for (int rep_ = 0; rep_ < REP(1); ++rep_) {
    {
        PHASE_PTRS();
        pg8::Gemm g{ACT, WT0, NTOK, N0, DM}; pg8::StaticOrder S; S.init(NTOK, N0, G, bx);
        pg8::EpiProj E{H, N0, SIDE, N0 / 256 - 1, nullptr, 0, 0, g_fox, g_dsa, g_kidx, ROPE, (LAS float*)(lds + LDS_XCH_OFF), 0.08838834764831845f * LOG2E};
        if (PROBE_PLAIN && rep_ < REP(1) - 1) { pg8::EpiBf16 Ep{H, N0, SIDE, N0 / 256 - 1, nullptr, 0}; pg8::gemm_phase<pg8::EpiBf16, pg8::StaticOrder, true, true>(lds, g, S, Ep); }
        else pg8::gemm_phase<pg8::EpiProj, pg8::StaticOrder, true, true>(lds, g, S, E);
        pg8::Gemm g2{WT0 + (size_t)N0 * DM, ACT, 2048, NTOK, DM}; pg8::StaticOrder S2; S2.init(2048, NTOK, G, bx);
        pg8::EpiBf16 E2{VT, VTP, nullptr, -1, nullptr, 0};
        pg8::gemm_phase<pg8::EpiBf16, pg8::StaticOrder, true, true>(lds, g2, S2, E2);
        if ((G == 256) ? (bx >= 160) : true) {
            constexpr int IO = 32 * (DM / 32), I1 = 32 * (N1T / 32);
            const int nw_ = (G == 256) ? 96 * 8 : NGW, w0_ = (G == 256) ? (bx - 160) * 8 + wave : gw;
            LAS float* scr = (LAS float*)(lds + wave * 8448);
            __syncthreads();
            for (int it = w0_; it < IO + I1; it += nw_) {
                if (it < IO) p0_transpose_item(w_out_even, DM, 2, WO0, scr, it, DM / 32, lane);
                else p0_transpose_item(w_in_odd, ODD_IN, 1, WT1, scr, it - IO, N1T / 32, lane);
            }
        }
    }
    GRID_SYNC();
    }
    for (int rep_ = 0; rep_ < REP(3); ++rep_) {
    {
        PHASE_PTRS();
    for (;;) {
        __syncthreads();
        if (tid == 0) lctl[0] = (int)atomicAdd(&ctl[0 + rep_], 1u);
        __syncthreads();
        const int it = lctl[0];
        if (it >= 768 + 384) break;
        if (it >= 512 && it < 896) {
            const int id = it - 512, k12 = id >> 5, bh = id & 31, b = bh >> 3, h = bh & 7;
            const int qb = (int)((0x405162776543ULL >> (4 * k12)) & 15ULL);
            const int chunk = (k12 == 0 || k12 == 6 || k12 == 8 || k12 == 10) ? -1 : ((k12 >= 1 && k12 <= 4) ? 0 : 1);
            if (tid == 0) {
                unsigned sp_ = 0;
                while (__hip_atomic_load(ctl + 192 + b * 8 + qb, __ATOMIC_RELAXED, __HIP_MEMORY_SCOPE_AGENT) < 16u) { __builtin_amdgcn_s_sleep(4); if (++sp_ > (1u << 22)) break; }
                __builtin_amdgcn_fence(__ATOMIC_ACQUIRE, "agent"); asm volatile("s_waitcnt vmcnt(0)" ::: "memory");
            }
            __syncthreads();
            const bf16_t* hb = H + (size_t)b * SEQ * N0;
            float mref;
            { float gq = fmaxf(fabsf(g_dsa[lane]), fabsf(g_dsa[64 + lane])), gk = fmaxf(fabsf(g_dsa[128 + lane]), fabsf(g_dsa[192 + lane]));
#pragma unroll
              for (int o_ = 1; o_ < 64; o_ <<= 1) { gq = fmaxf(gq, __shfl_xor(gq, o_)); gk = fmaxf(gk, __shfl_xor(gk, o_)); }
              mref = fminf(16.5f * gq * gk, 60.f); }
            float* part = (float*)((unsigned char*)out + DO_PART) + (size_t)((bh * 4 + (qb & 3)) * 2) * (8 * 66 * 64);
            attn_unit<128, 1>(lds, hb + C_DQ + h * 128, N0, hb + C_DK + h * 128, N0, VT + (size_t)(1024 + h * 128) * VTP + b * SEQ, hb + C_DG + h * 128, N0,
                              ACT + (size_t)b * SEQ * DM + 1024 + h * 128, nullptr, MASK + (size_t)b * SEQ * 32, 0.f, mref, qb, chunk, part, ctl + 64 + bh * 4 + (qb & 3), lctl);
        } else if (it >= 896) {
            const int if_ = it - 896; const int qb = 7 - (if_ >> 5), bh = if_ & 31, b = bh >> 3, h = bh & 7;
            const bf16_t* hb = H + (size_t)b * SEQ * N0;
            LAS float* c2 = (LAS float*)(lds + 73728); LAS float* wtot = c2 + 2048;
            {
                const int nrows = (qb + 1) * 256; const float bias = b_f[h];
                float v4[4] = {0.f, 0.f, 0.f, 0.f}, run = 0.f;
                if (4 * tid < nrows) {
                    float fv[4];
#pragma unroll
                    for (int e = 0; e < 4; ++e) fv[e] = SIDE[(size_t)(b * SEQ + 4 * tid + e) * 256 + 64 + h];
#pragma unroll
                    for (int e = 0; e < 4; ++e) { const float f = fv[e] + bias; run += (fminf(f, 0.f) - log1pf(expf(-fabsf(f)))) * LOG2E; v4[e] = run; }
                }
                float incl = run;
#pragma unroll
                for (int o = 1; o < 64; o <<= 1) { const float tt = __shfl_up(incl, o); if (lane >= o) incl += tt; }
                if (lane == 63) wtot[wave] = incl;
                if (wave == 0) {
                    float gq = fmaxf(fabsf(g_fox[lane]), fabsf(g_fox[64 + lane])), gk = fmaxf(fabsf(g_fox[128 + lane]), fabsf(g_fox[192 + lane]));
#pragma unroll
                    for (int o = 1; o < 64; o <<= 1) { gq = fmaxf(gq, __shfl_xor(gq, o)); gk = fmaxf(gk, __shfl_xor(gk, o)); }
                    if (lane == 0) wtot[8] = 33.0f * gq * gk;
                }
                __syncthreads();
                float pre = incl - run;
                for (int w_ = 0; w_ < wave; ++w_) pre += wtot[w_];
                if (4 * tid < nrows) { const f32x4 cv = {v4[0] + pre, v4[1] + pre, v4[2] + pre, v4[3] + pre}; *(LAS f32x4*)(c2 + 4 * tid) = cv; *(LAS f32x4*)(c2 + 2304 + 4 * tid) = -cv; }
                __syncthreads();
            }
            attn_unit<128, 0>(lds, hb + C_FQ + h * 128, N0, hb + C_FK + h * 128, N0, VT + (size_t)(h * 128) * VTP + b * SEQ, hb + C_FG + h * 128, N0,
                              ACT + (size_t)b * SEQ * DM + h * 128, (const float*)c2, nullptr, 0.f, wtot[8], qb, -1, nullptr, nullptr, nullptr, (const float*)(c2 + 2304));
        } else {
            const int j = it, u = 127 - (j >> 2), b = j & 3;
            idx_unit(lds, H, SIDE, MASK, b, u);
            asm volatile("s_waitcnt vmcnt(0)" ::: "memory");
            __syncthreads();
            if (tid == 0) __hip_atomic_fetch_add(ctl + 192 + b * 8 + (u >> 4), 1u, __ATOMIC_RELAXED, __HIP_MEMORY_SCOPE_AGENT);
        }
    }
    }
    GRID_SYNC();
    }
    {
        PHASE_PTRS();
        pg8::Gemm g{ACT, WO0, NTOK, DM, DM}; pg8::StaticOrder S; S.init(NTOK, DM, G, bx);
        for (int rep_ = 0; rep_ < REP(5); ++rep_) {
        pg8::EpiResXg E{x, out, DM, norm_odd, XG, (rep_ < REP(5) - 1) ? (float*)H : SS};
        pg8::gemm_phase<pg8::EpiResXg, pg8::StaticOrder, true, true>(lds, g, S, E);
        if (rep_ < REP(5) - 1) GRID_SYNC();
        }
    }
    GRID_SYNC();
    for (int rep_ = 0; rep_ < REP(7); ++rep_) {
    {
        PHASE_PTRS();
        pg8::Gemm g{XG, WT1, NTOK, N1, DM}; pg8::StaticOrder S; S.init(NTOK, N1, G, bx);
        pg8::EpiProj E{H, N1, nullptr, -1, SS, 1, 1, g_swa, nullptr, nullptr, ROPE, (LAS float*)(lds + LDS_XCH_OFF), 0.125f * LOG2E};
        pg8::gemm_phase<pg8::EpiProj, pg8::StaticOrder, true, true>(lds, g, S, E);
        pg8::Gemm g2{WT1 + (size_t)N1 * DM, XG, 256, NTOK, DM}; pg8::StaticOrder S2; S2.init(256, NTOK, G, (bx + G - 64) % G);
        pg8::EpiBf16 E2{VT1, VTP, nullptr, -1, SS, 2};
        pg8::gemm_phase<pg8::EpiBf16, pg8::StaticOrder, true, true>(lds, g2, S2, E2);
        {
            constexpr int IO = 32 * (DM / 32);
            const bool mine_ = (G == 256) ? (bx >= 96) : true;
            const int nw_ = (G == 256) ? 160 * 8 : NGW, w0_ = (G == 256) ? (bx - 96) * 8 + wave : gw;
            LAS float* scr = (LAS float*)(lds + wave * 8448);
            __syncthreads();
            if (mine_) for (int it = w0_; it < IO; it += nw_) p0_transpose_item(w_out_odd, DM, 2, WO1, scr, it, DM / 32, lane);
        }
    }
    GRID_SYNC();
    }
    for (int rep_ = 0; rep_ < REP(9); ++rep_) {
    {
        PHASE_PTRS();
    for (int it = bx; it < NB * 4 * 16; it += G) {
        const int j = it & 15, kvh = (it >> 4) & 3, b = it >> 6;
        swa_unit(lds, H + (size_t)b * SEQ * N1, VT1 + (size_t)(kvh * 64) * VTP + b * SEQ, ACT + (size_t)b * SEQ * DM, sinks, g_swa, kvh, j);
    }
    }
    GRID_SYNC();
    }
    for (int es_ = 0; es_ < PROBE_SYNCS; ++es_) GRID_SYNC();
    {
        PHASE_PTRS();
        pg8::Gemm g{ACT, WO1, NTOK, DM, DM}; pg8::StaticOrder S; S.init(NTOK, DM, G, bx);
        for (int rep_ = 0; rep_ < REP(10); ++rep_) {
        pg8::EpiResF32 E{out, (rep_ < REP(10) - 1) ? (float*)H : out, DM};
        pg8::gemm_phase<pg8::EpiResF32, pg8::StaticOrder, true, true>(lds, g, S, E);
        if (rep_ < REP(10) - 1) GRID_SYNC();
        }
    }
}

extern "C" void kernel_launch(void* const* d_in, const int* in_sizes, int n_in, void* d_out, int out_size, void* d_ws, size_t ws_size, hipStream_t stream) {
    static int grid = 0;
    if (grid == 0) {
        if (n_in != 13 || out_size != NTOK * DM || ws_size < WS_END) { fprintf(stderr, "kernel_launch: unexpected shapes (n_in %d, out %d, ws %zu need %zu)\n", n_in, out_size, ws_size, (size_t)WS_END); grid = -1; return; }
        int dev = 0, cus = 0, per_cu = 0;
        hipGetDevice(&dev);
        hipDeviceGetAttribute(&cus, hipDeviceAttributeMultiprocessorCount, dev);
        hipFuncSetAttribute((const void*)fwd_megakernel, hipFuncAttributeMaxDynamicSharedMemorySize, LDS_BYTES);
        hipOccupancyMaxActiveBlocksPerMultiprocessor(&per_cu, (const void*)fwd_megakernel, 512, LDS_BYTES);
        if (per_cu < 1) per_cu = 1;
        if (per_cu > 1) per_cu = 1;
        (void)hipGetLastError();
        grid = cus * per_cu;
    }
    if (grid < 0) return;
    if (hipMemsetAsync((char*)d_ws + WS_CTL, 0, CTL_BYTES, stream) != hipSuccess) { fprintf(stderr, "kernel_launch: memset failed\n"); return; }
    Params p{};
    for (int i = 0; i < 13; ++i) p.in[i] = (const float*)d_in[i];
    p.out = (float*)d_out; p.ws = (unsigned char*)d_ws;
    void* args[] = {&p};
    hipError_t e = hipLaunchCooperativeKernel((const void*)fwd_megakernel, dim3(grid), dim3(512), args, LDS_BYTES, stream);
    if (e != hipSuccess) fprintf(stderr, "cooperative launch failed: %s (grid %d)\n", hipGetErrorString(e), grid);
}
```
